# Optimizing an MI355X kernel written in HIP

```python
import jax, jax.numpy as jnp
from jax import lax
import numpy as np

D_MODEL = 2048
BATCH = 16
SEQ = 2048
DEPTH = 4

CHUNK = 64
N_MIXERS = 3
N_A = (DEPTH + 2) // 3
N_B = (DEPTH + 1) // 3
N_C = DEPTH // 3

A_HEADS = 16
A_HEAD_DIM = D_MODEL // A_HEADS
A_WIDTH = A_HEADS * A_HEAD_DIM
LEFT_CHUNKS = 8
BAND = (LEFT_CHUNKS + 1) * CHUNK
REL_CLIP = 256
N_REL = 2 * REL_CLIP + 1

RG_WIDTH = 5 * D_MODEL // 4
RG_BLOCKS = 16
RG_BLOCK = RG_WIDTH // RG_BLOCKS
CONV_WIDTH = 4
RG_C = 8.0

C_HEADS = 16
C_HEAD_DIM = D_MODEL // C_HEADS
C_WIDTH = C_HEADS * C_HEAD_DIM
Q_BLOCK = 128

RMS_EPS = 1e-6
NEG_INF = -1e30

kernel_name = "hybrid_chunked_attn_rglru_fox_trunk"


def rmsnorm(x, g):
    xf = x.astype(jnp.float32)
    y = xf * lax.rsqrt(jnp.mean(xf * xf, axis=-1, keepdims=True) + RMS_EPS)
    return (y * g.astype(jnp.float32)).astype(x.dtype)


def chunked_rel_attention(q, k, v, rel_bias):
    B, S, H, dh = q.shape
    n_chunks = S // CHUNK
    pad = LEFT_CHUNKS * CHUNK
    kp = jnp.pad(k, ((0, 0), (pad, 0), (0, 0), (0, 0)))
    vp = jnp.pad(v, ((0, 0), (pad, 0), (0, 0), (0, 0)))
    dist = pad + jnp.arange(CHUNK)[:, None] - jnp.arange(BAND)[None, :]
    idx = jnp.clip(dist, -REL_CLIP, REL_CLIP) + REL_CLIP
    bias = rel_bias.astype(jnp.float32)[:, idx]
    scale = A_HEAD_DIM ** -0.5
    band_offsets = jnp.arange(BAND)

    def one_chunk(c):
        start = c * CHUNK
        qb = lax.dynamic_slice_in_dim(q, start, CHUNK, axis=1)
        kb = lax.dynamic_slice_in_dim(kp, start, BAND, axis=1)
        vb = lax.dynamic_slice_in_dim(vp, start, BAND, axis=1)
        s = jnp.einsum('bqhd,bkhd->bhqk', qb, kb).astype(jnp.float32) * scale + bias
        valid = (start - pad + band_offsets) >= 0
        s = jnp.where(valid[None, None, None, :], s, NEG_INF)
        p = jax.nn.softmax(s, axis=-1).astype(vb.dtype)
        return jnp.einsum('bhqk,bkhd->bqhd', p, vb)

    out = lax.map(one_chunk, jnp.arange(n_chunks))
    return out.transpose(1, 0, 2, 3, 4).reshape(B, S, H * dh)


def mixer_a(h, w_in, rel_bias, w_out):
    B, S, _ = h.shape
    proj = jnp.einsum('bsd,de->bse', h, w_in)
    q, k, v, g = jnp.split(proj, 4, axis=-1)
    shp = (B, S, A_HEADS, A_HEAD_DIM)
    o = chunked_rel_attention(q.reshape(shp), k.reshape(shp), v.reshape(shp), rel_bias)
    return jnp.einsum('bse,ed->bsd', o * jax.nn.silu(g), w_out)


def causal_depthwise_conv(x, w, b):
    S = x.shape[1]
    xp = jnp.pad(x, ((0, 0), (CONV_WIDTH - 1, 0), (0, 0)))
    y = xp[:, 0:S] * w[0]
    for t in range(1, CONV_WIDTH):
        y = y + xp[:, t:t + S] * w[t]
    return y + b


def rg_lru(x, w_a, b_a, w_x, b_x, lam):
    B, S, _ = x.shape
    xf = x.astype(jnp.float32)
    xb = xf.reshape(B, S, RG_BLOCKS, RG_BLOCK)
    r = jax.nn.sigmoid(jnp.einsum('bsnd,nde->bsne', xb, w_a.astype(jnp.float32)) + b_a.astype(jnp.float32))
    i = jax.nn.sigmoid(jnp.einsum('bsnd,nde->bsne', xb, w_x.astype(jnp.float32)) + b_x.astype(jnp.float32))
    r = r.reshape(B, S, RG_WIDTH)
    i = i.reshape(B, S, RG_WIDTH)
    log_a = -RG_C * jax.nn.softplus(-lam.astype(jnp.float32)) * r
    a = jnp.exp(log_a)
    u = jnp.sqrt(-jnp.expm1(2.0 * log_a)) * (i * xf)

    def combine(left, right):
        a1, b1 = left
        a2, b2 = right
        return a1 * a2, a2 * b1 + b2

    _, hs = lax.associative_scan(combine, (a, u), axis=1)
    return hs.astype(x.dtype)


def mixer_b(h, w_in, conv_w, conv_b, gate_a_w, gate_a_b, gate_x_w, gate_x_b, lam, w_out):
    proj = jnp.einsum('bsd,de->bse', h, w_in)
    xr, g = jnp.split(proj, 2, axis=-1)
    xr = causal_depthwise_conv(xr, conv_w, conv_b)
    hr = rg_lru(xr, gate_a_w, gate_a_b, gate_x_w, gate_x_b, lam)
    return jnp.einsum('bse,ed->bsd', hr * jax.nn.silu(g), w_out)


def forgetting_attention(q, k, v, log_f):
    B, S, H, dh = q.shape
    n_blocks = S // Q_BLOCK
    cum = jnp.cumsum(log_f, axis=1).transpose(0, 2, 1)
    kpos = jnp.arange(S)
    scale = C_HEAD_DIM ** -0.5

    def one_block(blk):
        start = blk * Q_BLOCK
        qb = lax.dynamic_slice_in_dim(q, start, Q_BLOCK, axis=1)
        cq = lax.dynamic_slice_in_dim(cum, start, Q_BLOCK, axis=2)
        s = jnp.einsum('bqhd,bkhd->bhqk', qb, k).astype(jnp.float32) * scale
        s = s + (cq[..., :, None] - cum[..., None, :])
        qpos = start + jnp.arange(Q_BLOCK)
        s = jnp.where((kpos[None, :] <= qpos[:, None])[None, None], s, NEG_INF)
        p = jax.nn.softmax(s, axis=-1).astype(v.dtype)
        return jnp.einsum('bhqk,bkhd->bqhd', p, v)

    out = lax.map(one_block, jnp.arange(n_blocks))
    return out.transpose(1, 0, 2, 3, 4).reshape(B, S, H * dh)


def mixer_c(h, w_in, f_bias, w_out):
    B, S, _ = h.shape
    proj = jnp.einsum('bsd,de->bse', h, w_in)
    q, k, v, g, f_logit = jnp.split(proj, [C_WIDTH, 2 * C_WIDTH, 3 * C_WIDTH, 4 * C_WIDTH], axis=-1)
    shp = (B, S, C_HEADS, C_HEAD_DIM)
    log_f = jax.nn.log_sigmoid(f_logit.astype(jnp.float32) + f_bias.astype(jnp.float32))
    o = forgetting_attention(q.reshape(shp), k.reshape(shp), v.reshape(shp), log_f)
    return jnp.einsum('bse,ed->bsd', o * jax.nn.silu(g), w_out)


def _dense(k, shape, fan_in):
    return jax.random.normal(k, shape, jnp.float32) * (fan_in ** -0.5)


def setup_inputs(seed: int = 0) -> dict:
    key = jax.random.key(seed)
    ks = jax.random.split(key, 20)
    x = jax.random.normal(ks[0], (BATCH, SEQ, D_MODEL), jnp.float32)
    norm_pre = 1.0 + 0.02 * jax.random.normal(ks[1], (DEPTH, D_MODEL), jnp.float32)
    norm_post = 1.0 + 0.02 * jax.random.normal(ks[2], (DEPTH, D_MODEL), jnp.float32)
    a_w_in = _dense(ks[3], (N_A, D_MODEL, 4 * A_WIDTH), D_MODEL)
    a_rel_bias = 0.1 * jax.random.normal(ks[4], (N_A, A_HEADS, N_REL), jnp.float32)
    a_w_out = _dense(ks[5], (N_A, A_WIDTH, D_MODEL), A_WIDTH)
    b_w_in = _dense(ks[6], (N_B, D_MODEL, 2 * RG_WIDTH), D_MODEL)
    b_conv_w = _dense(ks[7], (N_B, CONV_WIDTH, RG_WIDTH), CONV_WIDTH)
    b_conv_b = 0.01 * jax.random.normal(ks[8], (N_B, RG_WIDTH), jnp.float32)
    b_gate_a_w = _dense(ks[9], (N_B, RG_BLOCKS, RG_BLOCK, RG_BLOCK), RG_BLOCK)
    b_gate_a_b = 0.01 * jax.random.normal(ks[10], (N_B, RG_BLOCKS, RG_BLOCK), jnp.float32)
    b_gate_x_w = _dense(ks[11], (N_B, RG_BLOCKS, RG_BLOCK, RG_BLOCK), RG_BLOCK)
    b_gate_x_b = 0.01 * jax.random.normal(ks[12], (N_B, RG_BLOCKS, RG_BLOCK), jnp.float32)
    u = jax.random.uniform(ks[13], (N_B, RG_WIDTH), jnp.float32, minval=0.9, maxval=0.999)
    a0 = u ** (1.0 / RG_C)
    b_lambda = jnp.log(a0) - jnp.log1p(-a0)
    b_w_out = _dense(ks[14], (N_B, RG_WIDTH, D_MODEL), RG_WIDTH)
    c_w_in = _dense(ks[15], (N_C, D_MODEL, 4 * C_WIDTH + C_HEADS), D_MODEL)
    c_f_bias = 3.0 + 0.5 * jax.random.normal(ks[16], (N_C, C_HEADS), jnp.float32)
    c_w_out = _dense(ks[17], (N_C, C_WIDTH, D_MODEL), C_WIDTH)
    return {"x": x, "norm_pre": norm_pre, "norm_post": norm_post,
            "a_w_in": a_w_in, "a_rel_bias": a_rel_bias, "a_w_out": a_w_out,
            "b_w_in": b_w_in, "b_conv_w": b_conv_w, "b_conv_b": b_conv_b,
            "b_gate_a_w": b_gate_a_w, "b_gate_a_b": b_gate_a_b,
            "b_gate_x_w": b_gate_x_w, "b_gate_x_b": b_gate_x_b,
            "b_lambda": b_lambda, "b_w_out": b_w_out,
            "c_w_in": c_w_in, "c_f_bias": c_f_bias, "c_w_out": c_w_out}


def reference(x, norm_pre, norm_post, a_w_in, a_rel_bias, a_w_out, b_w_in, b_conv_w, b_conv_b,
              b_gate_a_w, b_gate_a_b, b_gate_x_w, b_gate_x_b, b_lambda, b_w_out,
              c_w_in, c_f_bias, c_w_out):
    for i in range(DEPTH):
        m = i % N_MIXERS
        j = i // N_MIXERS
        h = rmsnorm(x, norm_pre[i])
        if m == 0:
            y = mixer_a(h, a_w_in[j], a_rel_bias[j], a_w_out[j])
        elif m == 1:
            y = mixer_b(h, b_w_in[j], b_conv_w[j], b_conv_b[j], b_gate_a_w[j], b_gate_a_b[j],
                        b_gate_x_w[j], b_gate_x_b[j], b_lambda[j], b_w_out[j])
        else:
            y = mixer_c(h, c_w_in[j], c_f_bias[j], c_w_out[j])
        x = x + rmsnorm(y, norm_post[i])
    return x
```

```cpp
#include <hip/hip_runtime.h>
#include <hip/hip_cooperative_groups.h>
#include <cstdio>
#include <cstdint>
namespace cg = cooperative_groups;
namespace pg8 {
#define PG8_LAS __attribute__((address_space(3)))
typedef unsigned short bf16_t;
typedef short bf16x8 __attribute__((ext_vector_type(8)));
typedef float f32x4 __attribute__((ext_vector_type(4)));
typedef unsigned u32x4 __attribute__((ext_vector_type(4)));
constexpr int BM = 256, BK = 64, HALF = 128, HTB = HALF * BK * 2  , STAGE_BYTES = 8 * HTB, NXCD = 8, WGM = 8;

__host__ __device__ __forceinline__ int lds_byte(int r, int c) { const int st = (r >> 4) * 2 + (c >> 5), rr = r & 15, cc = c & 31, ob = rr * 64 + cc * 2; return st * 1024 + (ob ^ (((ob >> 9) & 1) << 5)); }
__host__ __device__ __forceinline__ void stage_rc(int b, int& R, int& C) { const int st = b / 1024, sb = b % 1024, swz = sb ^ (((sb >> 9) & 1) << 5); R = (st >> 1) * 16 + swz / 64; C = (st & 1) * 32 + (swz % 64) / 2; }
__host__ __device__ __forceinline__ int perm32(int rho) { const int n = rho >> 4, i = rho & 15; return 8 * (i >> 2) + 4 * n + (i & 3); }

struct Unit { int pm, pn; };
struct Gemm { const bf16_t* A; const bf16_t* Bt; int M, N, K; };

struct StaticOrder {
    int nM, nN, nwg, G, c;
    __host__ __device__ void init(int M, int N, int G_, int c_) { nM = M / BM; nN = N / BM; nwg = nM * nN; G = G_; c = c_; }
    __host__ __device__ bool next(int i, Unit& u) const {
        const long L = (long)i * G + c; if (L >= nwg) return false;
        int wgid = (int)L; { const int q = nwg / NXCD, r = nwg % NXCD, xcd = wgid % NXCD, off = wgid / NXCD; wgid = (xcd < r ? xcd * (q + 1) : r * (q + 1) + (xcd - r) * q) + off; }
        const int nig = WGM * nN, gid = wgid / nig, fm = gid * WGM, gsz = (nM - fm) < WGM ? (nM - fm) : WGM;
        u.pm = fm + ((wgid % nig) % gsz); u.pn = (wgid % nig) / gsz; return true;
    }
    __device__ __forceinline__ void a_ready(const Unit&) const {}
    __device__ __forceinline__ void done(const Unit&) const {}
};
__device__ __forceinline__ unsigned cvt_pk_bf16(float lo, float hi) { unsigned r; asm volatile("v_cvt_pk_bf16_f32 %0, %1, %2" : "=v"(r) : "v"(lo), "v"(hi)); return r; }
typedef float f32x2 __attribute__((ext_vector_type(2)));
struct EpiF32 {
    static constexpr bool PERM = false, AFTER_DRAIN = false;
    float* C; int ldc; const float* bias;
    __device__ __forceinline__ void operator()(const f32x4 (&acc)[2][2][4][2], const Unit& u, int wr, int wc, int fr, int fq) const {
        const int row0 = u.pm * BM + wr * 64 + fr, col0 = u.pn * BM + wc * 32 + 4 * fq;
        f32x4 bv[2][2];
#pragma unroll
        for (int bj = 0; bj < 2; ++bj)
#pragma unroll
            for (int n = 0; n < 2; ++n) bv[bj][n] = bias ? *(const f32x4*)(bias + col0 + bj * HALF + n * 16) : (f32x4){0.f, 0.f, 0.f, 0.f};
#pragma unroll
        for (int ai = 0; ai < 2; ++ai)
#pragma unroll
            for (int m = 0; m < 4; ++m) { float* rowp = C + (size_t)(row0 + ai * HALF + m * 16) * ldc + col0;
#pragma unroll
                for (int bj = 0; bj < 2; ++bj)
#pragma unroll
                    for (int n = 0; n < 2; ++n) *(f32x4*)(rowp + bj * HALF + n * 16) = acc[ai][bj][m][n] + bv[bj][n]; }
    }
};
template <class Epi, class Sched>
__device__ __forceinline__ void gemm_phase(PG8_LAS unsigned char* lds, const Gemm g, const Sched& S, const Epi& E, const int tid_in) {
    const int tid = tid_in, wid = __builtin_amdgcn_readfirstlane(tid >> 6), lane = tid & 63, wr = wid >> 2, wc = wid & 3, fr = lane & 15, fq = lane >> 4;
    const int K = g.K, nt = K / BK;
    unsigned voffA[2], voffB[2];
#pragma unroll
    for (int i = 0; i < 2; ++i) { int R, C; stage_rc(tid * 16 + i * 8192, R, C); const int Rb = Epi::PERM ? ((R & ~31) + perm32(R & 31)) : R;
        voffA[i] = (unsigned)(R * K + C) * 2u; voffB[i] = (unsigned)(Rb * K + C) * 2u; }
    const size_t kstep = (size_t)(BK * 2);
    const size_t hstep = (size_t)HALF * K * 2;
    const size_t tstep = 2 * hstep;
    const unsigned ldsw = (unsigned)wid * 1024u;
    const int aoff = lds_byte(wr * 64 + fr, fq * 8), boff = lds_byte(wc * 32 + fr, fq * 8);
#define PG8_SA(b, h) (((b) * 2 + (h)) * HTB)
#define PG8_SB(b, h) ((4 + (b) * 2 + (h)) * HTB)
#define PG8_STAGE(bufoff, gbase, voff) do { _Pragma("unroll") for (int _i = 0; _i < 2; ++_i) \
        __builtin_amdgcn_global_load_lds((const unsigned*)((const char*)(gbase) + (voff)[_i]), (PG8_LAS unsigned*)(lds + (bufoff) + ldsw + _i * 8192), 16, 0, 0); } while (0)
#define PG8_LDA(dst, b, h) do { _Pragma("unroll") for (int m = 0; m < 4; ++m) _Pragma("unroll") for (int k = 0; k < 2; ++k) dst[m][k] = *(const PG8_LAS bf16x8*)(lds + PG8_SA(b, h) + aoff + m * 2048 + k * 1024); } while (0)
#define PG8_LDB(dst, b, h) do { _Pragma("unroll") for (int n = 0; n < 2; ++n) _Pragma("unroll") for (int k = 0; k < 2; ++k) dst[n][k] = *(const PG8_LAS bf16x8*)(lds + PG8_SB(b, h) + boff + n * 2048 + k * 1024); } while (0)
#define PG8_MMA(ai, bj, At, Bt) do { __builtin_amdgcn_s_setprio(1); _Pragma("unroll") for (int m = 0; m < 4; ++m) _Pragma("unroll") for (int n = 0; n < 2; ++n) _Pragma("unroll") for (int k = 0; k < 2; ++k) \
        acc[ai][bj][m][n] = __builtin_amdgcn_mfma_f32_16x16x32_bf16(Bt[n][k], At[m][k], acc[ai][bj][m][n], 0, 0, 0); __builtin_amdgcn_s_setprio(0); } while (0)
#define PG8_WAIT_V(n) asm volatile("s_waitcnt vmcnt(" #n ")" ::: "memory")
#define PG8_WAIT_L(n) asm volatile("s_waitcnt lgkmcnt(" #n ")" ::: "memory")
#define PG8_BAR __builtin_amdgcn_s_barrier()
#define PG8_SCHED __builtin_amdgcn_sched_barrier(0)
    Unit cur, nxt; int ui = 0;
    if (!S.next(0, cur)) return;
    f32x4 acc[2][2][4][2];
#pragma unroll
    for (int a = 0; a < 2; ++a)
#pragma unroll
        for (int b = 0; b < 2; ++b)
#pragma unroll
            for (int m = 0; m < 4; ++m)
#pragma unroll
                for (int n = 0; n < 2; ++n) acc[a][b][m][n] = (f32x4){0.f, 0.f, 0.f, 0.f};
    bf16x8 At[4][2], B0[2][2], B1[2][2];
    const char* cA = (const char*)g.A + (size_t)cur.pm * tstep; const char* cB = (const char*)g.Bt + (size_t)cur.pn * tstep;
    S.a_ready(cur);
    PG8_STAGE(PG8_SB(0, 0), cB, voffB); PG8_STAGE(PG8_SA(0, 0), cA, voffA); PG8_STAGE(PG8_SB(0, 1), cB + hstep, voffB); PG8_STAGE(PG8_SA(0, 1), cA + hstep, voffA);
    if (wr == 1) PG8_BAR;
    PG8_WAIT_V(4); PG8_BAR;
    PG8_STAGE(PG8_SB(1, 0), cB + kstep, voffB); PG8_STAGE(PG8_SA(1, 0), cA + kstep, voffA); PG8_STAGE(PG8_SB(1, 1), cB + hstep + kstep, voffB);
    PG8_WAIT_V(6); PG8_BAR;
    for (;;) {
        const bool has_next = S.next(ui + 1, nxt);
        const char* nA = has_next ? (const char*)g.A + (size_t)nxt.pm * tstep : cA; const char* nB = has_next ? (const char*)g.Bt + (size_t)nxt.pn * tstep : cB;
        for (int t = 0; t < nt; t += 2) {
            const bool last = (t == nt - 2);
            const char* a1 = cA + (size_t)(t + 1) * kstep;
            const char* a2 = last ? nA : cA + (size_t)(t + 2) * kstep; const char* b2 = last ? nB : cB + (size_t)(t + 2) * kstep;
            const char* a3 = a2 + kstep; const char* b3 = b2 + kstep;
            if (last && has_next) S.a_ready(nxt);
            PG8_LDB(B0, 0, 0); PG8_SCHED; PG8_LDA(At, 0, 0); PG8_STAGE(PG8_SA(1, 1), a1 + hstep, voffA);
            PG8_WAIT_L(8); PG8_BAR; PG8_WAIT_L(0); PG8_MMA(0, 0, At, B0); PG8_BAR; PG8_SCHED;
            PG8_LDB(B1, 0, 1); PG8_STAGE(PG8_SB(0, 0), b2, voffB);
            PG8_BAR; PG8_WAIT_L(0); PG8_MMA(0, 1, At, B1); PG8_BAR;
            PG8_LDA(At, 0, 1); PG8_STAGE(PG8_SA(0, 0), a2, voffA);
            PG8_BAR; PG8_WAIT_L(0); PG8_MMA(1, 0, At, B0); PG8_BAR; PG8_SCHED;
            PG8_STAGE(PG8_SB(0, 1), b2 + hstep, voffB);
            PG8_WAIT_V(6); PG8_BAR; PG8_MMA(1, 1, At, B1); PG8_BAR;
            PG8_LDB(B0, 1, 0); PG8_SCHED; PG8_LDA(At, 1, 0); PG8_STAGE(PG8_SA(0, 1), a2 + hstep, voffA);
            PG8_WAIT_L(8); PG8_BAR; PG8_WAIT_L(0); PG8_MMA(0, 0, At, B0); PG8_BAR; PG8_SCHED;
            PG8_LDB(B1, 1, 1); PG8_STAGE(PG8_SB(1, 0), b3, voffB);
            PG8_BAR; PG8_WAIT_L(0); PG8_MMA(0, 1, At, B1); PG8_BAR;
            PG8_LDA(At, 1, 1); PG8_STAGE(PG8_SA(1, 0), a3, voffA);
            PG8_BAR; PG8_WAIT_L(0); PG8_MMA(1, 0, At, B0); PG8_BAR; PG8_SCHED;
            PG8_STAGE(PG8_SB(1, 1), b3 + hstep, voffB);
            PG8_WAIT_V(6); PG8_BAR; PG8_MMA(1, 1, At, B1); PG8_BAR;
        }
        if constexpr (!Epi::AFTER_DRAIN) { E(acc, cur, wr, wc, fr, fq); S.done(cur); }
        if (!has_next) break;
#pragma unroll
        for (int a = 0; a < 2; ++a)
#pragma unroll
            for (int b = 0; b < 2; ++b)
#pragma unroll
                for (int m = 0; m < 4; ++m)
#pragma unroll
                    for (int n = 0; n < 2; ++n) acc[a][b][m][n] = (f32x4){0.f, 0.f, 0.f, 0.f};
        cur = nxt; cA = nA; cB = nB; ++ui;
    }
    PG8_WAIT_V(0);
    if (wr == 0) PG8_BAR;
    PG8_BAR;
    if constexpr (Epi::AFTER_DRAIN) { E.fused(acc, cur, wr, wc, fr, fq, lds, wid, lane); S.done(cur); }
#undef PG8_SA
#undef PG8_SB
#undef PG8_STAGE
#undef PG8_LDA
#undef PG8_LDB
#undef PG8_MMA
#undef PG8_WAIT_V
#undef PG8_WAIT_L
#undef PG8_BAR
#undef PG8_SCHED
}
}

#define LAS __attribute__((address_space(3)))
typedef unsigned short bf16_t;
typedef short bf16x8 __attribute__((ext_vector_type(8)));
typedef short s16x4 __attribute__((ext_vector_type(4)));
typedef float f32x4 __attribute__((ext_vector_type(4)));
typedef float f32x2 __attribute__((ext_vector_type(2)));
typedef float f32x16 __attribute__((ext_vector_type(16)));
typedef unsigned u32x4 __attribute__((ext_vector_type(4)));
typedef unsigned u32x2 __attribute__((ext_vector_type(2)));
typedef __bf16 bf16v2 __attribute__((ext_vector_type(2)));

constexpr int DM = 2048, SEQ = 2048, NBATCH = 16, MTOK = NBATCH * SEQ;
constexpr int NHEAD = 16, HD = 128;
constexpr int NA = 8192, NBP = 5120, RGW = 2560, NCF = 8208, NREL = 513;
constexpr float RMS_EPS = 1e-6f, LOG2E = 1.4426950408889634f;
constexpr float QSCALE = 0.08838834764831845f * 1.4426950408889634f;
constexpr size_t MiB = (size_t)1 << 20;
constexpr size_t WS_WA_IN = 0, WS_WA_OUT = 64 * MiB, WS_WB_IN = 80 * MiB, WS_WB_OUT = 100 * MiB, WS_WC_IN = 110 * MiB, WS_WC_OUT = 142 * MiB;
constexpr size_t WS_LOGF = 150 * MiB, WS_CUMB = 152 * MiB, WS_GW = 154 * MiB, WS_ACT = 160 * MiB, WS_PROJ = 320 * MiB, WS_END = 832 * MiB;
constexpr int LDS_BYTES = 147456;
constexpr int NPHASE = 17;

struct Params { const float* in[18]; float* out; unsigned char* ws; int ph_lo, ph_hi; };

__device__ __forceinline__ unsigned pk2(float a, float b) { const bf16v2 v = __builtin_convertvector((f32x2){a, b}, bf16v2); return __builtin_bit_cast(unsigned, v); }
__device__ __forceinline__ float bflo(unsigned w) { return __uint_as_float(w << 16); }
__device__ __forceinline__ float bfhi(unsigned w) { return __uint_as_float(w & 0xffff0000u); }
__device__ __forceinline__ float wave_sum(float v) {
#pragma unroll
    for (int o = 1; o < 64; o <<= 1) v += __shfl_xor(v, o);
    return v;
}
__device__ __forceinline__ float fast_sigmoid(float z) { return __builtin_amdgcn_rcpf(1.0f + __builtin_amdgcn_exp2f(-LOG2E * z)); }

namespace pg8 {
struct EpiProj {
    static constexpr bool PERM = true, AFTER_DRAIN = false;
    bf16_t* O; int ldc; int q_end; float qscale; int g_begin;
    __device__ __forceinline__ void operator()(const f32x4 (&acc)[2][2][4][2], const Unit& u, int wr, int wc, int fr, int fq) const {
        const int row0 = u.pm * BM + wr * 64 + fr; const int colt = u.pn * BM;
        const int col0 = colt + wc * 32 + 8 * fq;
        const bool is_g = colt >= g_begin; const float sc = colt < q_end ? qscale : 1.0f;
#pragma unroll
        for (int ai = 0; ai < 2; ++ai)
#pragma unroll
            for (int m = 0; m < 4; ++m) { bf16_t* rowp = O + (size_t)(row0 + ai * HALF + m * 16) * ldc + col0;
#pragma unroll
                for (int bj = 0; bj < 2; ++bj) { f32x4 v0 = acc[ai][bj][m][0] * sc, v1 = acc[ai][bj][m][1] * sc;
                    if (is_g) {
#pragma unroll
                        for (int j = 0; j < 4; ++j) { v0[j] = v0[j] * __builtin_amdgcn_rcpf(1.0f + __builtin_amdgcn_exp2f(-1.4426950408889634f * v0[j])); v1[j] = v1[j] * __builtin_amdgcn_rcpf(1.0f + __builtin_amdgcn_exp2f(-1.4426950408889634f * v1[j])); } }
                    u32x4 w; w.x = cvt_pk_bf16(v0[0], v0[1]); w.y = cvt_pk_bf16(v0[2], v0[3]); w.z = cvt_pk_bf16(v1[0], v1[1]); w.w = cvt_pk_bf16(v1[2], v1[3]);
                    *(u32x4*)(rowp + bj * HALF) = w; } }
    }
};
}

__device__ __forceinline__ void transpose_item(const float* W, int ldw, int nblk, int K, bf16_t* WT, LAS float* scr, int item, int lane) {
    const int kb = item / nblk, nb = item - kb * nblk, k0 = 64 * kb, n0 = 32 * nb;
#pragma unroll 8
    for (int i = 0; i < 32; ++i) { const int kk = 2 * i + (lane >> 5); scr[kk * 33 + (lane & 31)] = W[(size_t)(k0 + kk) * ldw + n0 + (lane & 31)]; }
    asm volatile("s_waitcnt lgkmcnt(0)" ::: "memory");
    const int c = lane & 7;
#pragma unroll
    for (int j = 0; j < 4; ++j) { const int n = (lane >> 3) + 8 * j; const LAS float* s = scr + (8 * c) * 33 + n;
        u32x4 o; o.x = pk2(s[0 * 33], s[1 * 33]); o.y = pk2(s[2 * 33], s[3 * 33]); o.z = pk2(s[4 * 33], s[5 * 33]); o.w = pk2(s[6 * 33], s[7 * 33]);
        *(u32x4*)(WT + (size_t)(n0 + n) * K + k0 + 8 * c) = o; }
    asm volatile("s_waitcnt lgkmcnt(0)" ::: "memory");
}
__device__ __forceinline__ void norm_row_to_bf16(const float* xrow, const float* g, bf16_t* orow, int lane) {
    f32x4 v[8]; float s = 0.f;
#pragma unroll
    for (int j = 0; j < 8; ++j) { v[j] = ((const f32x4*)xrow)[lane + 64 * j]; s += (v[j].x * v[j].x + v[j].y * v[j].y) + (v[j].z * v[j].z + v[j].w * v[j].w); }
    const float rstd = 1.0f / sqrtf(wave_sum(s) * (1.0f / DM) + RMS_EPS);
#pragma unroll
    for (int j = 0; j < 8; ++j) { const f32x4 gg = ((const f32x4*)g)[lane + 64 * j]; const f32x4 o = v[j] * rstd * gg;
        u32x2 w; w.x = pk2(o.x, o.y); w.y = pk2(o.z, o.w); ((u32x2*)orow)[lane + 64 * j] = w; }
}
__device__ __forceinline__ void prologue_phase(const Params& p, LAS unsigned char* L, int G, int blk, int wave, int lane) {
    LAS float* scr = (LAS float*)(L + wave * 16384);
    const int gw = blk * 8 + wave, NGW = G * 8;
    unsigned char* ws = p.ws;
    constexpr int I_AIN = 32 * 256, I_AOUT = 32 * 64, I_BIN = 32 * 160, I_BOUT = 40 * 64, I_CIN = 32 * 256, I_COUT = 32 * 64;
    constexpr int NITEMS = 2 * I_AIN + 2 * I_AOUT + I_BIN + I_BOUT + I_CIN + I_COUT;
    for (int it = gw; it < NITEMS; it += NGW) {
        int r = it;
        if (r < I_AIN) { transpose_item(p.in[3], NA, 256, DM, (bf16_t*)(ws + WS_WA_IN), scr, r, lane); continue; } r -= I_AIN;
        if (r < I_AOUT) { transpose_item(p.in[5], DM, 64, DM, (bf16_t*)(ws + WS_WA_OUT), scr, r, lane); continue; } r -= I_AOUT;
        if (r < I_BIN) { transpose_item(p.in[6], NBP, 160, DM, (bf16_t*)(ws + WS_WB_IN), scr, r, lane); continue; } r -= I_BIN;
        if (r < I_BOUT) { transpose_item(p.in[14], DM, 64, RGW, (bf16_t*)(ws + WS_WB_OUT), scr, r, lane); continue; } r -= I_BOUT;
        if (r < I_CIN) { transpose_item(p.in[15], NCF, 256, DM, (bf16_t*)(ws + WS_WC_IN), scr, r, lane); continue; } r -= I_CIN;
        if (r < I_COUT) { transpose_item(p.in[17], DM, 64, DM, (bf16_t*)(ws + WS_WC_OUT), scr, r, lane); continue; } r -= I_COUT;
        if (r < I_AIN) { transpose_item(p.in[3] + (size_t)DM * NA, NA, 256, DM, (bf16_t*)(ws + WS_WA_IN + 32 * MiB), scr, r, lane); continue; } r -= I_AIN;
        transpose_item(p.in[5] + (size_t)DM * DM, DM, 64, DM, (bf16_t*)(ws + WS_WA_OUT + 8 * MiB), scr, r, lane);
    }
    for (int it = gw * 64 + lane; it < 2 * 16 * 10 * 5 * 64; it += NGW * 64) { const int l = it & 63, f = it >> 6, ks = f % 5, ct = (f / 5) % 10, nb = (f / 50) % 16, gate = f / 800;
        const float* src = (gate ? p.in[11] : p.in[9]) + (size_t)nb * 25600 + (32 * ks + 8 * (l >> 4)) * 160 + ct * 16 + (l & 15);
        u32x4 o; o.x = pk2(src[0], src[160]); o.y = pk2(src[320], src[480]); o.z = pk2(src[640], src[800]); o.w = pk2(src[960], src[1120]);
        *(u32x4*)(ws + WS_GW + (size_t)it * 16) = o; }
    bf16_t* HB = (bf16_t*)(ws + WS_ACT);
    for (int m = gw; m < MTOK; m += NGW) norm_row_to_bf16(p.in[0] + (size_t)m * DM, p.in[1], HB + (size_t)m * DM, lane);
}

__device__ __forceinline__ void row_phase(const float* Y, const float* xin, float* xout, const float* gpost, const float* gpre, bf16_t* HB,
                                          const float* wf, const float* fbias, float* LOGF, int gw, int NGW, int lane) {
    for (int m = gw; m < MTOK; m += NGW) {
        const f32x4* yr = (const f32x4*)(Y + (size_t)m * DM); const f32x4* xr = (const f32x4*)(xin + (size_t)m * DM); f32x4* orow = (f32x4*)(xout + (size_t)m * DM);
        f32x4 v[8]; float s = 0.f;
#pragma unroll
        for (int j = 0; j < 8; ++j) { v[j] = yr[lane + 64 * j]; s += (v[j].x * v[j].x + v[j].y * v[j].y) + (v[j].z * v[j].z + v[j].w * v[j].w); }
        const float rstd_y = 1.0f / sqrtf(wave_sum(s) * (1.0f / DM) + RMS_EPS);
        float s2 = 0.f;
#pragma unroll
        for (int j = 0; j < 8; ++j) { const f32x4 gg = ((const f32x4*)gpost)[lane + 64 * j]; const f32x4 xx = xr[lane + 64 * j];
            v[j] = xx + v[j] * rstd_y * gg; orow[lane + 64 * j] = v[j];
            s2 += (v[j].x * v[j].x + v[j].y * v[j].y) + (v[j].z * v[j].z + v[j].w * v[j].w); }
        if (gpre) {
            const float rstd = 1.0f / sqrtf(wave_sum(s2) * (1.0f / DM) + RMS_EPS);
#pragma unroll
            for (int j = 0; j < 8; ++j) { const f32x4 gg = ((const f32x4*)gpre)[lane + 64 * j]; v[j] = v[j] * rstd * gg;
                u32x2 w; w.x = pk2(v[j].x, v[j].y); w.y = pk2(v[j].z, v[j].w); ((u32x2*)(HB + (size_t)m * DM))[lane + 64 * j] = w; }
            if (wf) {
                f32x4 a0 = {0.f, 0.f, 0.f, 0.f}, a1 = a0, a2 = a0, a3 = a0;
#pragma unroll
                for (int j = 0; j < 8; ++j)
#pragma unroll
                    for (int e = 0; e < 4; ++e) { const f32x4* wp = (const f32x4*)(wf + (size_t)(4 * lane + 256 * j + e) * NCF); const float hv = v[j][e];
                        a0 += wp[0] * hv; a1 += wp[1] * hv; a2 += wp[2] * hv; a3 += wp[3] * hv; }
                float mine = 0.f;
#pragma unroll
                for (int q = 0; q < 4; ++q) { const float t0 = wave_sum(a0[q]), t1 = wave_sum(a1[q]), t2 = wave_sum(a2[q]), t3 = wave_sum(a3[q]);
                    mine = lane == q ? t0 : mine; mine = lane == 4 + q ? t1 : mine; mine = lane == 8 + q ? t2 : mine; mine = lane == 12 + q ? t3 : mine; }
                if (lane < 16) { const float z = mine + fbias[lane]; const float lf = fminf(z, 0.f) - log1pf(expf(-fabsf(z))); LOGF[(size_t)m * 16 + lane] = lf; }
            }
        }
    }
}

__device__ __forceinline__ void cumsum_phase(const float* LOGF, float* CUMB, LAS float* sc, int G, int blk, int tid) {
    const int lane = tid & 63, wave = tid >> 6;
    for (int bh = blk; bh < NBATCH * NHEAD; bh += G) {
        const int b = bh >> 4, hh = bh & 15; const int t0 = 4 * tid;
        float v[4];
#pragma unroll
        for (int e = 0; e < 4; ++e) v[e] = LOGF[((size_t)(b * SEQ + t0 + e)) * 16 + hh];
        v[1] += v[0]; v[2] += v[1]; v[3] += v[2];
        float incl = v[3];
#pragma unroll
        for (int o = 1; o < 64; o <<= 1) { const float t = __shfl_up(incl, o); if (lane >= o) incl += t; }
        if (lane == 63) sc[wave] = incl;
        __syncthreads();
        float woff = 0.f;
        for (int i = 0; i < wave; ++i) woff += sc[i];
        const float excl = incl - v[3] + woff;
        f32x4 o; o.x = -(excl + v[0]) * LOG2E; o.y = -(excl + v[1]) * LOG2E; o.z = -(excl + v[2]) * LOG2E; o.w = -(excl + v[3]) * LOG2E;
        *(f32x4*)(CUMB + (size_t)bh * SEQ + t0) = o;
        __syncthreads();
    }
}

__device__ __forceinline__ unsigned off_b(unsigned row, unsigned ch) { return 256u * row + 16u * (ch ^ (((row & 3u) << 2) | ((row >> 2) & 3u))); }
#define MFMA32(a, b, c) __builtin_amdgcn_mfma_f32_32x32x16_bf16((a), (b), (c), 0, 0, 0)
template <int MODE>
__device__ __forceinline__ void attn_phase(LAS unsigned char* L, const bf16_t* PROJ, bf16_t* ACT, const float* bias_src, int G, int blk, const int tid) {
    const int  lane = tid & 63, w = __builtin_amdgcn_readfirstlane(tid >> 6), c = lane & 31, hi = lane >> 5;
    LAS float* T = (LAS float*)(L + 65536);
    const int srow = tid >> 4, sch = tid & 15;
    const unsigned soff0 = off_b(srow, sch), soff1 = off_b(srow + 32, sch);
    const unsigned kaddr = 256u * c + 16u * ((unsigned)hi ^ (((c & 3u) << 2) | ((c >> 2) & 3u)));
    const unsigned blk16 = (lane >> 4) & 1, q4 = (lane & 15) >> 2, p4 = lane & 3;
    const unsigned vbase0 = 256u * (4u * hi + q4) + 8u * (p4 & 1u);
    const unsigned vb = 64u * q4 + 16u * (((2u * blk16 + (p4 >> 1)) ^ (unsigned)hi));
    unsigned va[4][2];
#pragma unroll
    for (int db = 0; db < 4; ++db)
#pragma unroll
        for (int t = 0; t < 2; ++t) va[db][t] = vbase0 + (vb ^ (unsigned)(64 * db + 32 * t)) + 2048u * t;
    for (int unit = blk; unit < NBATCH * NHEAD * 8; unit += G) {
        const int bh = unit & 255, qb = unit >> 8, b = bh >> 4, h = bh & 15;
        __syncthreads();
        if (MODE == 0) { for (int i = tid; i < 639; i += 512) { int d = i - 63; d = d < -256 ? -256 : (d > 256 ? 256 : d); T[i] = bias_src[h * NREL + d + 256] * LOG2E; } }
        else { for (int i = tid; i < (qb + 1) * 256; i += 512) T[i] = bias_src[(size_t)bh * SEQ + i]; }
        const int qrow = qb * 256 + w * 32 + c;
        const bf16_t* qp = PROJ + (size_t)(b * SEQ + qrow) * NA + h * HD + 8 * hi;
        bf16x8 qf[8];
#pragma unroll
        for (int s = 0; s < 8; ++s) qf[s] = *(const bf16x8*)(qp + 16 * s);
        const int kt_hi = 4 * qb + 3, kt_lo = MODE == 0 ? (4 * qb - 8 > 0 ? 4 * qb - 8 : 0) : 0;
        const int cw = 4 * qb + (w >> 1);
        const bf16_t* kg = PROJ + (size_t)(b * SEQ + srow) * NA + DM + h * HD + sch * 8;
        u32x4 st0, st1, st2, st3;
        { const bf16_t* g0 = kg + (size_t)kt_lo * 64 * NA;
          st0 = *(const u32x4*)g0; st1 = *(const u32x4*)(g0 + (size_t)32 * NA); st2 = *(const u32x4*)(g0 + DM); st3 = *(const u32x4*)(g0 + (size_t)32 * NA + DM); }
        *(LAS u32x4*)(L + soff0) = st0; *(LAS u32x4*)(L + soff1) = st1; *(LAS u32x4*)(L + 32768 + soff0) = st2; *(LAS u32x4*)(L + 32768 + soff1) = st3;
        f32x16 o0, o1, o2, o3;
#pragma unroll
        for (int r = 0; r < 16; ++r) { o0[r] = 0.f; o1[r] = 0.f; o2[r] = 0.f; o3[r] = 0.f; }
        float mrun = -1e30f, lrun = 0.f;
        __syncthreads();
        int cur = 0;
        for (int kt = kt_lo; kt <= kt_hi; ++kt) {
            const bool more = kt < kt_hi;
            if (more) { const bf16_t* g0 = kg + (size_t)(kt + 1) * 64 * NA;
                st0 = *(const u32x4*)g0; st1 = *(const u32x4*)(g0 + (size_t)32 * NA); st2 = *(const u32x4*)(g0 + DM); st3 = *(const u32x4*)(g0 + (size_t)32 * NA + DM); }
            const bool active = MODE == 0 ? (kt >= cw - 8 && kt <= cw) : (kt <= cw);
            if (active) {
                LAS unsigned char* Kb = L + cur * 16384; LAS unsigned char* Vb = L + 32768 + cur * 16384;
                f32x16 s0, s1;
                if (MODE == 0) { const int base = qrow - kt * 64 + 63 - 4 * hi;
#pragma unroll
                    for (int r = 0; r < 16; ++r) { const int cr = (r & 3) + 8 * (r >> 2); s0[r] = T[base - cr]; s1[r] = T[base - 32 - cr]; } }
                else { const int base = kt * 64 + 4 * hi;
#pragma unroll
                    for (int r = 0; r < 16; ++r) { const int cr = (r & 3) + 8 * (r >> 2); s0[r] = T[base + cr]; s1[r] = T[base + 32 + cr]; } }
#pragma unroll
                for (int s = 0; s < 8; ++s) { const unsigned a = kaddr ^ (unsigned)(s << 5);
                    const bf16x8 k0 = *(const LAS bf16x8*)(Kb + a); const bf16x8 k1 = *(const LAS bf16x8*)(Kb + a + 8192);
                    s0 = MFMA32(k0, qf[s], s0); s1 = MFMA32(k1, qf[s], s1); if (s & 1) __builtin_amdgcn_sched_barrier(0); }
                if (MODE == 1 && kt == cw) {
                    const int rel = qrow - kt * 64 - 4 * hi;
#pragma unroll
                    for (int r = 0; r < 16; ++r) { const int cr = (r & 3) + 8 * (r >> 2);
                        s0[r] = cr <= rel ? s0[r] : -__builtin_inff(); s1[r] = cr + 32 <= rel ? s1[r] : -__builtin_inff(); } }
                float mx = fmaxf(s0[0], s1[0]);
#pragma unroll
                for (int r = 1; r < 16; ++r) mx = fmaxf(mx, fmaxf(s0[r], s1[r]));
                mx = fmaxf(mx, __shfl_xor(mx, 32));
                const float mn = fmaxf(mrun, mx), alpha = __builtin_amdgcn_exp2f(mrun - mn); mrun = mn;
                float ps = 0.f;
#pragma unroll
                for (int r = 0; r < 16; ++r) { s0[r] = __builtin_amdgcn_exp2f(s0[r] - mn); s1[r] = __builtin_amdgcn_exp2f(s1[r] - mn); ps += s0[r] + s1[r]; }
                lrun = lrun * alpha + ps;
                o0 *= alpha; o1 *= alpha; o2 *= alpha; o3 *= alpha;
                bf16x8 pb[4];
#pragma unroll
                for (int ks = 0; ks < 2; ++ks) { u32x4 a, bq;
                    a.x = pk2(s0[8 * ks + 0], s0[8 * ks + 1]); a.y = pk2(s0[8 * ks + 2], s0[8 * ks + 3]); a.z = pk2(s0[8 * ks + 4], s0[8 * ks + 5]); a.w = pk2(s0[8 * ks + 6], s0[8 * ks + 7]);
                    bq.x = pk2(s1[8 * ks + 0], s1[8 * ks + 1]); bq.y = pk2(s1[8 * ks + 2], s1[8 * ks + 3]); bq.z = pk2(s1[8 * ks + 4], s1[8 * ks + 5]); bq.w = pk2(s1[8 * ks + 6], s1[8 * ks + 7]);
                    pb[ks] = __builtin_bit_cast(bf16x8, a); pb[2 + ks] = __builtin_bit_cast(bf16x8, bq); }
#define PV_STEP(OD, DB) _Pragma("unroll") for (int ks = 0; ks < 4; ++ks) { \
                    const s16x4 lo = __builtin_amdgcn_ds_read_tr16_b64_v4i16((LAS s16x4*)(Vb + va[DB][0] + 4096 * ks)); \
                    const s16x4 hh = __builtin_amdgcn_ds_read_tr16_b64_v4i16((LAS s16x4*)(Vb + va[DB][1] + 4096 * ks)); \
                    const bf16x8 vf = __builtin_shufflevector(lo, hh, 0, 1, 2, 3, 4, 5, 6, 7); OD = MFMA32(vf, pb[ks], OD); }
                __builtin_amdgcn_sched_barrier(0); PV_STEP(o0, 0) __builtin_amdgcn_sched_barrier(0); PV_STEP(o1, 1) __builtin_amdgcn_sched_barrier(0); PV_STEP(o2, 2) __builtin_amdgcn_sched_barrier(0); PV_STEP(o3, 3) __builtin_amdgcn_sched_barrier(0);
#undef PV_STEP
            }
            if (more) { LAS unsigned char* Kn = L + (cur ^ 1) * 16384; LAS unsigned char* Vn = L + 32768 + (cur ^ 1) * 16384;
                *(LAS u32x4*)(Kn + soff0) = st0; *(LAS u32x4*)(Kn + soff1) = st1; *(LAS u32x4*)(Vn + soff0) = st2; *(LAS u32x4*)(Vn + soff1) = st3; }
            __syncthreads();
            cur ^= 1;
        }
        lrun += __shfl_xor(lrun, 32);
        const float inv = 1.0f / lrun;
        const bf16_t* gp = PROJ + (size_t)(b * SEQ + qrow) * NA + 3 * DM + h * HD + 4 * hi;
        bf16_t* op = ACT + (size_t)(b * SEQ + qrow) * DM + h * HD + 4 * hi;
#define O_STORE(OD, DB) _Pragma("unroll") for (int g4 = 0; g4 < 4; ++g4) { const u32x2 sg = *(const u32x2*)(gp + 32 * DB + 8 * g4); \
            u32x2 ov; ov.x = pk2(OD[4 * g4 + 0] * inv * bflo(sg.x), OD[4 * g4 + 1] * inv * bfhi(sg.x)); ov.y = pk2(OD[4 * g4 + 2] * inv * bflo(sg.y), OD[4 * g4 + 3] * inv * bfhi(sg.y)); \
            *(u32x2*)(op + 32 * DB + 8 * g4) = ov; }
        O_STORE(o0, 0) O_STORE(o1, 1) O_STORE(o2, 2) O_STORE(o3, 3)
#undef O_STORE
    }
}

#define MFMA16(a, b, c) __builtin_amdgcn_mfma_f32_16x16x32_bf16((a), (b), (c), 0, 0, 0)
constexpr int XC_LD = 168, LA_LD = 164;
__device__ __forceinline__ void rglru_phase(LAS unsigned char* L, const bf16_t* PROJ, bf16_t* ACT, const float* conv_w, const float* conv_b, const bf16x8* GW, const float* gab,
                                            const float* gxb, const float* lam, int G, int blk, const int tid) {
    const int  lane = tid & 63, w = __builtin_amdgcn_readfirstlane(tid >> 6), fr = lane & 15, fq = lane >> 4;
    LAS bf16_t* XC = (LAS bf16_t*)L;
    LAS float* LA = (LAS float*)(L + 21504);
    LAS float* LU = (LAS float*)(L + 21504 + 41984);
    LAS float* CW = (LAS float*)(L + 21504 + 2 * 41984);
    for (int unit = blk; unit < NBATCH * 16; unit += G) {
        const int b = unit >> 4, nb = unit & 15, ch0 = nb * 160;
        __syncthreads();
        for (int i = tid; i < 800; i += 512) { const int j = i / 160, ch = i - j * 160; CW[i] = j < 4 ? conv_w[j * RGW + ch0 + ch] : conv_b[ch0 + ch]; }
        bf16x8 wa0[5], wx0[5], wa1[5], wx1[5];
        const int col0 = w * 16 + fr, col1 = (8 + (w >> 2)) * 16 + fr;
        { const bf16x8* ga0 = GW + ((size_t)((0 * 16 + nb) * 10 + w) * 5) * 64 + lane; const bf16x8* gx0 = GW + ((size_t)((1 * 16 + nb) * 10 + w) * 5) * 64 + lane;
          const bf16x8* ga1 = GW + ((size_t)((0 * 16 + nb) * 10 + 8 + (w >> 2)) * 5) * 64 + lane; const bf16x8* gx1 = GW + ((size_t)((1 * 16 + nb) * 10 + 8 + (w >> 2)) * 5) * 64 + lane;
#pragma unroll
          for (int ks = 0; ks < 5; ++ks) { wa0[ks] = ga0[ks * 64]; wx0[ks] = gx0[ks * 64]; wa1[ks] = ga1[ks * 64]; wx1[ks] = gx1[ks * 64]; } }
        const float ba0 = gab[ch0 + col0], bx0 = gxb[ch0 + col0], ba1 = gab[ch0 + col1], bx1 = gxb[ch0 + col1];
        const float l0 = lam[ch0 + col0], l1 = lam[ch0 + col1];
        const float sp0 = -8.0f * LOG2E * (fmaxf(-l0, 0.f) + log1pf(expf(-fabsf(l0)))), sp1 = -8.0f * LOG2E * (fmaxf(-l1, 0.f) + log1pf(expf(-fabsf(l1))));
        float hstate = 0.f;
        __syncthreads();
        for (int chunk = 0; chunk < SEQ / 64; ++chunk) {
            const int t0 = chunk * 64;
#pragma unroll
            for (int it = 0; it < 5; ++it) { const int i = tid + 512 * it, t = i / 40, c4 = (i - t * 40) * 4;
                f32x4 acc = *(const LAS f32x4*)(CW + 640 + c4);
#pragma unroll
                for (int j = 0; j < 4; ++j) { const int tt = t0 + t - 3 + j;
                    if (tt >= 0) { const u32x2 xv = *(const u32x2*)(PROJ + (size_t)(b * SEQ + tt) * NBP + ch0 + c4); const f32x4 cw4 = *(const LAS f32x4*)(CW + j * 160 + c4);
                        acc.x += bflo(xv.x) * cw4.x; acc.y += bfhi(xv.x) * cw4.y; acc.z += bflo(xv.y) * cw4.z; acc.w += bfhi(xv.y) * cw4.w; } }
                u32x2 o; o.x = pk2(acc.x, acc.y); o.y = pk2(acc.z, acc.w); *(LAS u32x2*)(XC + t * XC_LD + c4) = o; }
            __syncthreads();
#define GATE_TILE(RT, COL, WA, WX, BA, BX, SP) { f32x4 aa = {0.f, 0.f, 0.f, 0.f}, ax = {0.f, 0.f, 0.f, 0.f}; \
                _Pragma("unroll") for (int ks = 0; ks < 5; ++ks) { const bf16x8 af = *(const LAS bf16x8*)(XC + ((RT) * 16 + fr) * XC_LD + 32 * ks + 8 * fq); aa = MFMA16(af, WA[ks], aa); ax = MFMA16(af, WX[ks], ax); } \
                _Pragma("unroll") for (int rg = 0; rg < 4; ++rg) { const int t = (RT) * 16 + fq * 4 + rg; \
                    const float r = fast_sigmoid(aa[rg] + BA), ig = fast_sigmoid(ax[rg] + BX); const float a = __builtin_amdgcn_exp2f(SP * r); \
                    const float xv = __uint_as_float((unsigned)XC[t * XC_LD + (COL)] << 16); const float u = sqrtf(fmaxf(1.0f - a * a, 0.f)) * ig * xv; \
                    LA[t * LA_LD + (COL)] = a; LU[t * LA_LD + (COL)] = u; } }
#pragma unroll
            for (int rt = 0; rt < 4; ++rt) GATE_TILE(rt, col0, wa0, wx0, ba0, bx0, sp0)
            GATE_TILE((w & 3), col1, wa1, wx1, ba1, bx1, sp1)
#undef GATE_TILE
            __syncthreads();
            if (tid < 160) {
#pragma unroll 8
                for (int t = 0; t < 64; ++t) { hstate = LA[t * LA_LD + tid] * hstate + LU[t * LA_LD + tid]; LU[t * LA_LD + tid] = hstate; }
            }
            __syncthreads();
#pragma unroll
            for (int it = 0; it < 5; ++it) { const int i = tid + 512 * it, t = i / 40, c4 = (i - t * 40) * 4;
                const f32x4 hv = *(const LAS f32x4*)(LU + t * LA_LD + c4);
                const u32x2 sg = *(const u32x2*)(PROJ + (size_t)(b * SEQ + t0 + t) * NBP + RGW + ch0 + c4);
                u32x2 o; o.x = pk2(hv.x * bflo(sg.x), hv.y * bfhi(sg.x)); o.y = pk2(hv.z * bflo(sg.y), hv.w * bfhi(sg.y));
                *(u32x2*)(ACT + (size_t)(b * SEQ + t0 + t) * RGW + ch0 + c4) = o; }
        }
    }
}

#ifndef MK_LAUNCHES
#define MK_LAUNCHES 1
#endif
__global__ void __launch_bounds__(512, 2) hybrid_trunk_mega(Params p) {
    extern __shared__ __attribute__((aligned(16))) unsigned char lds_raw[];
    LAS unsigned char* L = (LAS unsigned char*)lds_raw;
    cg::grid_group grid = cg::this_grid();
    const int G = gridDim.x, blk = blockIdx.x;
    unsigned char* ws = p.ws;
    bf16_t* ACT = (bf16_t*)(ws + WS_ACT); bf16_t* PROJ = (bf16_t*)(ws + WS_PROJ); float* Y = (float*)(ws + WS_PROJ);
    float* LOGF = (float*)(ws + WS_LOGF); float* CUMB = (float*)(ws + WS_CUMB);
    for (int ph = p.ph_lo; ph < p.ph_hi; ++ph) {
        int tid = threadIdx.x; asm volatile("" : "+v"(tid));
        const int lane = tid & 63, wave = __builtin_amdgcn_readfirstlane(tid >> 6);
        if (ph == 0) {
#ifndef SKIP_PRO
            prologue_phase(p, L, G, blk, wave, lane);
#endif
        }
        else {
            const int layer = (ph - 1) >> 2, sub = (ph - 1) & 3, mix = layer % 3, j = layer / 3;
            if (sub == 0) {
                const bf16_t* Wt = mix == 0 ? (const bf16_t*)(ws + WS_WA_IN + (size_t)j * 32 * MiB) : mix == 1 ? (const bf16_t*)(ws + WS_WB_IN) : (const bf16_t*)(ws + WS_WC_IN);
                const int N = mix == 1 ? NBP : NA;
                if (mix == 2) cumsum_phase(LOGF, CUMB, (LAS float*)L, G, blk, tid);
                pg8::Gemm g{ACT, Wt, MTOK, N, DM}; pg8::StaticOrder S; S.init(MTOK, N, G, blk);
                pg8::EpiProj E{PROJ, N, mix == 1 ? 0 : DM, QSCALE, mix == 1 ? RGW : 3 * DM};
#ifndef SKIP_GEMM1
                pg8::gemm_phase<pg8::EpiProj, pg8::StaticOrder>(L, g, S, E, tid);
#endif
            } else if (sub == 1) {
#ifndef SKIP_ATTN0
                if (mix == 0) attn_phase<0>(L, PROJ, ACT, p.in[4] + (size_t)j * NHEAD * NREL, G, blk, tid);
#endif
#ifndef SKIP_RGLRU
                if (mix == 1) rglru_phase(L, PROJ, ACT, p.in[7], p.in[8], (const bf16x8*)(ws + WS_GW), p.in[10], p.in[12], p.in[13], G, blk, tid);
#endif
#ifndef SKIP_ATTN1
                if (mix == 2) attn_phase<1>(L, PROJ, ACT, CUMB, G, blk, tid);
#endif
            } else if (sub == 2) {
                const bf16_t* Wt = mix == 0 ? (const bf16_t*)(ws + WS_WA_OUT + (size_t)j * 8 * MiB) : mix == 1 ? (const bf16_t*)(ws + WS_WB_OUT) : (const bf16_t*)(ws + WS_WC_OUT);
                const int K = mix == 1 ? RGW : DM;
                pg8::Gemm g{ACT, Wt, MTOK, DM, K}; pg8::StaticOrder S; S.init(MTOK, DM, G, blk);
                pg8::EpiF32 E{Y, DM, nullptr};
#ifndef SKIP_GEMM2
                pg8::gemm_phase<pg8::EpiF32, pg8::StaticOrder>(L, g, S, E, tid);
#endif
            } else {
                const float* xin = layer == 0 ? p.in[0] : p.out;
                const float* gpre = layer < 3 ? p.in[1] + (size_t)(layer + 1) * DM : nullptr;
                const float* wf = (layer + 1) % 3 == 2 && layer < 3 ? p.in[15] + 4 * DM : nullptr;
#ifndef SKIP_ROW
                row_phase(Y, xin, p.out, p.in[2] + (size_t)layer * DM, gpre, ACT, wf, p.in[16], LOGF, blk * 8 + wave, G * 8, lane);
#endif
            }
        }
        if (ph + 1 < p.ph_hi) grid.sync();
    }
}

extern "C" void kernel_launch(void* const* d_in, const int* in_sizes, int n_in, void* d_out, int out_size, void* d_ws, size_t ws_size, hipStream_t stream) {
    static int grid = 0;
    if (grid == 0) {
        if (n_in != 18 || in_sizes[0] != MTOK * DM || out_size != MTOK * DM || ws_size < WS_END) {
            fprintf(stderr, "kernel_launch: unexpected shapes (n_in %d, in0 %d, out %d, ws %zu; need ws >= %zu)\n", n_in, n_in > 0 ? in_sizes[0] : -1, out_size, ws_size, (size_t)WS_END); grid = -1; return; }
        int dev = 0, cus = 0, per_cu = 0;
        (void)hipGetDevice(&dev); (void)hipDeviceGetAttribute(&cus, hipDeviceAttributeMultiprocessorCount, dev);
        if (hipFuncSetAttribute((const void*)hybrid_trunk_mega, hipFuncAttributeMaxDynamicSharedMemorySize, LDS_BYTES) != hipSuccess) { fprintf(stderr, "kernel_launch: hipFuncSetAttribute failed\n"); grid = -1; return; }
        if (hipOccupancyMaxActiveBlocksPerMultiprocessor(&per_cu, (const void*)hybrid_trunk_mega, 512, LDS_BYTES) != hipSuccess || per_cu < 1) { fprintf(stderr, "kernel_launch: occupancy query gave %d\n", per_cu); per_cu = 1; }
        (void)hipGetLastError();
        grid = cus * per_cu;
    }
    if (grid < 0) return;
    Params p{};
    for (int i = 0; i < 18; ++i) p.in[i] = (const float*)d_in[i];
    p.out = (float*)d_out; p.ws = (unsigned char*)d_ws;
#if MK_LAUNCHES == 1
    p.ph_lo = 0; p.ph_hi = NPHASE;
    void* args[] = {&p};
    const hipError_t e = hipLaunchCooperativeKernel((const void*)hybrid_trunk_mega, dim3(grid), dim3(512), args, LDS_BYTES, stream);
    if (e != hipSuccess) fprintf(stderr, "kernel_launch: cooperative launch failed: %s (grid %d)\n", hipGetErrorString(e), grid);
#else
    for (int ph = 0; ph < NPHASE; ++ph) { p.ph_lo = ph; p.ph_hi = ph + 1; hipLaunchKernelGGL(hybrid_trunk_mega, dim3(grid), dim3(512), LDS_BYTES, stream, p); }
#endif
}
```

```cpp
#include <hip/hip_runtime.h>
#include <hip/hip_cooperative_groups.h>
#include <cstdio>
#include <cstdint>
namespace cg = cooperative_groups;
namespace pg8 {
#define PG8_LAS __attribute__((address_space(3)))
typedef unsigned short bf16_t;
typedef short bf16x8 __attribute__((ext_vector_type(8)));
typedef float f32x4 __attribute__((ext_vector_type(4)));
typedef unsigned u32x4 __attribute__((ext_vector_type(4)));
constexpr int BM = 256, BK = 64, HALF = 128, HTB = HALF * BK * 2  , STAGE_BYTES = 8 * HTB, NXCD = 8, WGM = 8;

__host__ __device__ __forceinline__ int lds_byte(int r, int c) { const int st = (r >> 4) * 2 + (c >> 5), rr = r & 15, cc = c & 31, ob = rr * 64 + cc * 2; return st * 1024 + (ob ^ (((ob >> 9) & 1) << 5)); }
__host__ __device__ __forceinline__ void stage_rc(int b, int& R, int& C) { const int st = b / 1024, sb = b % 1024, swz = sb ^ (((sb >> 9) & 1) << 5); R = (st >> 1) * 16 + swz / 64; C = (st & 1) * 32 + (swz % 64) / 2; }
__host__ __device__ __forceinline__ int perm32(int rho) { const int n = rho >> 4, i = rho & 15; return 8 * (i >> 2) + 4 * n + (i & 3); }

struct Unit { int pm, pn; };
struct Gemm { const bf16_t* A; const bf16_t* Bt; int M, N, K; };

struct StaticOrder {
    int nM, nN, nwg, G, c;
    __host__ __device__ void init(int M, int N, int G_, int c_) { nM = M / BM; nN = N / BM; nwg = nM * nN; G = G_; c = c_; }
    __host__ __device__ bool next(int i, Unit& u) const {
        const long L = (long)i * G + c; if (L >= nwg) return false;
        int wgid = (int)L; { const int q = nwg / NXCD, r = nwg % NXCD, xcd = wgid % NXCD, off = wgid / NXCD; wgid = (xcd < r ? xcd * (q + 1) : r * (q + 1) + (xcd - r) * q) + off; }
        const int nig = WGM * nN, gid = wgid / nig, fm = gid * WGM, gsz = (nM - fm) < WGM ? (nM - fm) : WGM;
        u.pm = fm + ((wgid % nig) % gsz); u.pn = (wgid % nig) / gsz; return true;
    }
    __device__ __forceinline__ void a_ready(const Unit&) const {}
    __device__ __forceinline__ void done(const Unit&) const {}
};
__device__ __forceinline__ unsigned cvt_pk_bf16(float lo, float hi) { unsigned r; asm volatile("v_cvt_pk_bf16_f32 %0, %1, %2" : "=v"(r) : "v"(lo), "v"(hi)); return r; }
typedef float f32x2 __attribute__((ext_vector_type(2)));
struct EpiF32 {
    static constexpr bool PERM = false, AFTER_DRAIN = false;
    float* C; int ldc; const float* bias;
    __device__ __forceinline__ void operator()(const f32x4 (&acc)[2][2][4][2], const Unit& u, int wr, int wc, int fr, int fq) const {
        const int row0 = u.pm * BM + wr * 64 + fr, col0 = u.pn * BM + wc * 32 + 4 * fq;
        f32x4 bv[2][2];
#pragma unroll
        for (int bj = 0; bj < 2; ++bj)
#pragma unroll
            for (int n = 0; n < 2; ++n) bv[bj][n] = bias ? *(const f32x4*)(bias + col0 + bj * HALF + n * 16) : (f32x4){0.f, 0.f, 0.f, 0.f};
#pragma unroll
        for (int ai = 0; ai < 2; ++ai)
#pragma unroll
            for (int m = 0; m < 4; ++m) { float* rowp = C + (size_t)(row0 + ai * HALF + m * 16) * ldc + col0;
#pragma unroll
                for (int bj = 0; bj < 2; ++bj)
#pragma unroll
                    for (int n = 0; n < 2; ++n) *(f32x4*)(rowp + bj * HALF + n * 16) = acc[ai][bj][m][n] + bv[bj][n]; }
    }
};
template <class Epi, class Sched>
__device__ __forceinline__ void gemm_phase(PG8_LAS unsigned char* lds, const Gemm g, const Sched& S, const Epi& E, const int tid_in) {
    const int tid = tid_in, wid = __builtin_amdgcn_readfirstlane(tid >> 6), lane = tid & 63, wr = wid >> 2, wc = wid & 3, fr = lane & 15, fq = lane >> 4;
    const int K = g.K, nt = K / BK;
    unsigned voffA[2], voffB[2];
#pragma unroll
    for (int i = 0; i < 2; ++i) { int R, C; stage_rc(tid * 16 + i * 8192, R, C); const int Rb = Epi::PERM ? ((R & ~31) + perm32(R & 31)) : R;
        voffA[i] = (unsigned)(R * K + C) * 2u; voffB[i] = (unsigned)(Rb * K + C) * 2u; }
    const size_t kstep = (size_t)(BK * 2);
    const size_t hstep = (size_t)HALF * K * 2;
    const size_t tstep = 2 * hstep;
    const unsigned ldsw = (unsigned)wid * 1024u;
    const int aoff = lds_byte(wr * 64 + fr, fq * 8), boff = lds_byte(wc * 32 + fr, fq * 8);
#define PG8_SA(b, h) (((b) * 2 + (h)) * HTB)
#define PG8_SB(b, h) ((4 + (b) * 2 + (h)) * HTB)
#define PG8_STAGE(bufoff, gbase, voff) do { _Pragma("unroll") for (int _i = 0; _i < 2; ++_i) \
        __builtin_amdgcn_global_load_lds((const unsigned*)((const char*)(gbase) + (voff)[_i]), (PG8_LAS unsigned*)(lds + (bufoff) + ldsw + _i * 8192), 16, 0, 0); } while (0)
#define PG8_LDA(dst, b, h) do { _Pragma("unroll") for (int m = 0; m < 4; ++m) _Pragma("unroll") for (int k = 0; k < 2; ++k) dst[m][k] = *(const PG8_LAS bf16x8*)(lds + PG8_SA(b, h) + aoff + m * 2048 + k * 1024); } while (0)
#define PG8_LDB(dst, b, h) do { _Pragma("unroll") for (int n = 0; n < 2; ++n) _Pragma("unroll") for (int k = 0; k < 2; ++k) dst[n][k] = *(const PG8_LAS bf16x8*)(lds + PG8_SB(b, h) + boff + n * 2048 + k * 1024); } while (0)
#define PG8_MMA(ai, bj, At, Bt) do { __builtin_amdgcn_s_setprio(1); _Pragma("unroll") for (int m = 0; m < 4; ++m) _Pragma("unroll") for (int n = 0; n < 2; ++n) _Pragma("unroll") for (int k = 0; k < 2; ++k) \
        acc[ai][bj][m][n] = __builtin_amdgcn_mfma_f32_16x16x32_bf16(Bt[n][k], At[m][k], acc[ai][bj][m][n], 0, 0, 0); __builtin_amdgcn_s_setprio(0); } while (0)
#define PG8_WAIT_V(n) asm volatile("s_waitcnt vmcnt(" #n ")" ::: "memory")
#define PG8_WAIT_L(n) asm volatile("s_waitcnt lgkmcnt(" #n ")" ::: "memory")
#define PG8_BAR __builtin_amdgcn_s_barrier()
#define PG8_SCHED __builtin_amdgcn_sched_barrier(0)
    Unit cur, nxt; int ui = 0;
    if (!S.next(0, cur)) return;
    f32x4 acc[2][2][4][2];
#pragma unroll
    for (int a = 0; a < 2; ++a)
#pragma unroll
        for (int b = 0; b < 2; ++b)
#pragma unroll
            for (int m = 0; m < 4; ++m)
#pragma unroll
                for (int n = 0; n < 2; ++n) acc[a][b][m][n] = (f32x4){0.f, 0.f, 0.f, 0.f};
    bf16x8 At[4][2], B0[2][2], B1[2][2];
    const char* cA = (const char*)g.A + (size_t)cur.pm * tstep; const char* cB = (const char*)g.Bt + (size_t)cur.pn * tstep;
    S.a_ready(cur);
    PG8_STAGE(PG8_SB(0, 0), cB, voffB); PG8_STAGE(PG8_SA(0, 0), cA, voffA); PG8_STAGE(PG8_SB(0, 1), cB + hstep, voffB); PG8_STAGE(PG8_SA(0, 1), cA + hstep, voffA);
    if (wr == 1) PG8_BAR;
    PG8_WAIT_V(4); PG8_BAR;
    PG8_STAGE(PG8_SB(1, 0), cB + kstep, voffB); PG8_STAGE(PG8_SA(1, 0), cA + kstep, voffA); PG8_STAGE(PG8_SB(1, 1), cB + hstep + kstep, voffB);
    PG8_WAIT_V(6); PG8_BAR;
    for (;;) {
        const bool has_next = S.next(ui + 1, nxt);
        const char* nA = has_next ? (const char*)g.A + (size_t)nxt.pm * tstep : cA; const char* nB = has_next ? (const char*)g.Bt + (size_t)nxt.pn * tstep : cB;
        for (int t = 0; t < nt; t += 2) {
            const bool last = (t == nt - 2);
            const char* a1 = cA + (size_t)(t + 1) * kstep;
            const char* a2 = last ? nA : cA + (size_t)(t + 2) * kstep; const char* b2 = last ? nB : cB + (size_t)(t + 2) * kstep;
            const char* a3 = a2 + kstep; const char* b3 = b2 + kstep;
            if (last && has_next) S.a_ready(nxt);
            PG8_LDB(B0, 0, 0); PG8_SCHED; PG8_LDA(At, 0, 0); PG8_STAGE(PG8_SA(1, 1), a1 + hstep, voffA);
            PG8_WAIT_L(8); PG8_BAR; PG8_WAIT_L(0); PG8_MMA(0, 0, At, B0); PG8_BAR; PG8_SCHED;
            PG8_LDB(B1, 0, 1); PG8_STAGE(PG8_SB(0, 0), b2, voffB);
            PG8_BAR; PG8_WAIT_L(0); PG8_MMA(0, 1, At, B1); PG8_BAR;
            PG8_LDA(At, 0, 1); PG8_STAGE(PG8_SA(0, 0), a2, voffA);
            PG8_BAR; PG8_WAIT_L(0); PG8_MMA(1, 0, At, B0); PG8_BAR; PG8_SCHED;
            PG8_STAGE(PG8_SB(0, 1), b2 + hstep, voffB);
            PG8_WAIT_V(6); PG8_BAR; PG8_MMA(1, 1, At, B1); PG8_BAR;
            PG8_LDB(B0, 1, 0); PG8_SCHED; PG8_LDA(At, 1, 0); PG8_STAGE(PG8_SA(0, 1), a2 + hstep, voffA);
            PG8_WAIT_L(8); PG8_BAR; PG8_WAIT_L(0); PG8_MMA(0, 0, At, B0); PG8_BAR; PG8_SCHED;
            PG8_LDB(B1, 1, 1); PG8_STAGE(PG8_SB(1, 0), b3, voffB);
            PG8_BAR; PG8_WAIT_L(0); PG8_MMA(0, 1, At, B1); PG8_BAR;
            PG8_LDA(At, 1, 1); PG8_STAGE(PG8_SA(1, 0), a3, voffA);
            PG8_BAR; PG8_WAIT_L(0); PG8_MMA(1, 0, At, B0); PG8_BAR; PG8_SCHED;
            PG8_STAGE(PG8_SB(1, 1), b3 + hstep, voffB);
            PG8_WAIT_V(6); PG8_BAR; PG8_MMA(1, 1, At, B1); PG8_BAR;
        }
        if constexpr (!Epi::AFTER_DRAIN) { E(acc, cur, wr, wc, fr, fq); S.done(cur); }
        if (!has_next) break;
#pragma unroll
        for (int a = 0; a < 2; ++a)
#pragma unroll
            for (int b = 0; b < 2; ++b)
#pragma unroll
                for (int m = 0; m < 4; ++m)
#pragma unroll
                    for (int n = 0; n < 2; ++n) acc[a][b][m][n] = (f32x4){0.f, 0.f, 0.f, 0.f};
        cur = nxt; cA = nA; cB = nB; ++ui;
    }
    PG8_WAIT_V(0);
    if (wr == 0) PG8_BAR;
    PG8_BAR;
    if constexpr (Epi::AFTER_DRAIN) { E.fused(acc, cur, wr, wc, fr, fq, lds, wid, lane); S.done(cur); }
#undef PG8_SA
#undef PG8_SB
#undef PG8_STAGE
#undef PG8_LDA
#undef PG8_LDB
#undef PG8_MMA
#undef PG8_WAIT_V
#undef PG8_WAIT_L
#undef PG8_BAR
#undef PG8_SCHED
}
}

#define LAS __attribute__((address_space(3)))
typedef unsigned short bf16_t;
typedef short bf16x8 __attribute__((ext_vector_type(8)));
typedef short s16x4 __attribute__((ext_vector_type(4)));
typedef float f32x4 __attribute__((ext_vector_type(4)));
typedef float f32x2 __attribute__((ext_vector_type(2)));
typedef float f32x16 __attribute__((ext_vector_type(16)));
typedef unsigned u32x4 __attribute__((ext_vector_type(4)));
typedef unsigned u32x2 __attribute__((ext_vector_type(2)));
typedef __bf16 bf16v2 __attribute__((ext_vector_type(2)));

constexpr int DM = 2048, SEQ = 2048, NBATCH = 16, MTOK = NBATCH * SEQ;
constexpr int NHEAD = 16, HD = 128;
constexpr int NA = 8192, NBP = 5120, RGW = 2560, NCF = 8208, NREL = 513;
constexpr float RMS_EPS = 1e-6f, LOG2E = 1.4426950408889634f;
constexpr float QSCALE = 0.08838834764831845f * 1.4426950408889634f;
constexpr size_t MiB = (size_t)1 << 20;
constexpr size_t WS_WA_IN = 0, WS_WA_OUT = 64 * MiB, WS_WB_IN = 80 * MiB, WS_WB_OUT = 100 * MiB, WS_WC_IN = 110 * MiB, WS_WC_OUT = 142 * MiB;
constexpr size_t WS_LOGF = 150 * MiB, WS_CUMB = 152 * MiB, WS_GW = 154 * MiB, WS_BAR = 158 * MiB, WS_ACT = 160 * MiB, WS_PROJ = 320 * MiB, WS_END = 832 * MiB;
constexpr int LDS_BYTES = 147456;
constexpr int NPHASE = 17;

struct Params { const float* in[18]; float* out; unsigned char* ws; int ph_lo, ph_hi; };

__device__ __forceinline__ unsigned pk2(float a, float b) { const bf16v2 v = __builtin_convertvector((f32x2){a, b}, bf16v2); return __builtin_bit_cast(unsigned, v); }
__device__ __forceinline__ float bflo(unsigned w) { return __uint_as_float(w << 16); }
__device__ __forceinline__ float bfhi(unsigned w) { return __uint_as_float(w & 0xffff0000u); }
__device__ __forceinline__ float wave_sum(float v) {
#pragma unroll
    for (int o = 1; o < 64; o <<= 1) v += __shfl_xor(v, o);
    return v;
}
__device__ __forceinline__ float fast_sigmoid(float z) { return __builtin_amdgcn_rcpf(1.0f + __builtin_amdgcn_exp2f(-LOG2E * z)); }

namespace pg8 {
struct EpiProj {
    static constexpr bool PERM = true, AFTER_DRAIN = false;
    bf16_t* O; int ldc; int q_end; float qscale; int g_begin;
    __device__ __forceinline__ void operator()(const f32x4 (&acc)[2][2][4][2], const Unit& u, int wr, int wc, int fr, int fq) const {
        const int row0 = u.pm * BM + wr * 64 + fr; const int colt = u.pn * BM;
        const int col0 = colt + wc * 32 + 8 * fq;
        const bool is_g = colt >= g_begin; const float sc = colt < q_end ? qscale : 1.0f;
#pragma unroll
        for (int ai = 0; ai < 2; ++ai)
#pragma unroll
            for (int m = 0; m < 4; ++m) { bf16_t* rowp = O + (size_t)(row0 + ai * HALF + m * 16) * ldc + col0;
#pragma unroll
                for (int bj = 0; bj < 2; ++bj) { f32x4 v0 = acc[ai][bj][m][0] * sc, v1 = acc[ai][bj][m][1] * sc;
                    if (is_g) {
#pragma unroll
                        for (int j = 0; j < 4; ++j) { v0[j] = v0[j] * __builtin_amdgcn_rcpf(1.0f + __builtin_amdgcn_exp2f(-1.4426950408889634f * v0[j])); v1[j] = v1[j] * __builtin_amdgcn_rcpf(1.0f + __builtin_amdgcn_exp2f(-1.4426950408889634f * v1[j])); } }
                    u32x4 w; w.x = cvt_pk_bf16(v0[0], v0[1]); w.y = cvt_pk_bf16(v0[2], v0[3]); w.z = cvt_pk_bf16(v1[0], v1[1]); w.w = cvt_pk_bf16(v1[2], v1[3]);
                    *(u32x4*)(rowp + bj * HALF) = w; } }
    }
};
}

__device__ __forceinline__ void transpose_item(const float* W, int ldw, int nblk, int K, bf16_t* WT, LAS float* scr, int item, int lane) {
    const int kb = item / nblk, nb = item - kb * nblk, k0 = 64 * kb, n0 = 32 * nb;
#pragma unroll 8
    for (int i = 0; i < 32; ++i) { const int kk = 2 * i + (lane >> 5); scr[kk * 33 + (lane & 31)] = W[(size_t)(k0 + kk) * ldw + n0 + (lane & 31)]; }
    asm volatile("s_waitcnt lgkmcnt(0)" ::: "memory");
    const int c = lane & 7;
#pragma unroll
    for (int j = 0; j < 4; ++j) { const int n = (lane >> 3) + 8 * j; const LAS float* s = scr + (8 * c) * 33 + n;
        u32x4 o; o.x = pk2(s[0 * 33], s[1 * 33]); o.y = pk2(s[2 * 33], s[3 * 33]); o.z = pk2(s[4 * 33], s[5 * 33]); o.w = pk2(s[6 * 33], s[7 * 33]);
        *(u32x4*)(WT + (size_t)(n0 + n) * K + k0 + 8 * c) = o; }
    asm volatile("s_waitcnt lgkmcnt(0)" ::: "memory");
}
__device__ __forceinline__ void norm_row_to_bf16(const float* xrow, const float* g, bf16_t* orow, int lane) {
    f32x4 v[8]; float s = 0.f;
#pragma unroll
    for (int j = 0; j < 8; ++j) { v[j] = ((const f32x4*)xrow)[lane + 64 * j]; s += (v[j].x * v[j].x + v[j].y * v[j].y) + (v[j].z * v[j].z + v[j].w * v[j].w); }
    const float rstd = 1.0f / sqrtf(wave_sum(s) * (1.0f / DM) + RMS_EPS);
#pragma unroll
    for (int j = 0; j < 8; ++j) { const f32x4 gg = ((const f32x4*)g)[lane + 64 * j]; const f32x4 o = v[j] * rstd * gg;
        u32x2 w; w.x = pk2(o.x, o.y); w.y = pk2(o.z, o.w); ((u32x2*)orow)[lane + 64 * j] = w; }
}
__device__ __forceinline__ void prologue_phase(const Params& p, LAS unsigned char* L, int G, int blk, int wave, int lane) {
    LAS float* scr = (LAS float*)(L + wave * 16384);
    const int gw = blk * 8 + wave, NGW = G * 8;
    unsigned char* ws = p.ws;
    constexpr int I_AIN = 32 * 256, I_AOUT = 32 * 64, I_BIN = 32 * 160, I_BOUT = 40 * 64, I_CIN = 32 * 256, I_COUT = 32 * 64;
    constexpr int NITEMS = 2 * I_AIN + 2 * I_AOUT + I_BIN + I_BOUT + I_CIN + I_COUT;
    for (int it = gw; it < NITEMS; it += NGW) {
        int r = it;
        if (r < I_AIN) { transpose_item(p.in[3], NA, 256, DM, (bf16_t*)(ws + WS_WA_IN), scr, r, lane); continue; } r -= I_AIN;
        if (r < I_AOUT) { transpose_item(p.in[5], DM, 64, DM, (bf16_t*)(ws + WS_WA_OUT), scr, r, lane); continue; } r -= I_AOUT;
        if (r < I_BIN) { transpose_item(p.in[6], NBP, 160, DM, (bf16_t*)(ws + WS_WB_IN), scr, r, lane); continue; } r -= I_BIN;
        if (r < I_BOUT) { transpose_item(p.in[14], DM, 64, RGW, (bf16_t*)(ws + WS_WB_OUT), scr, r, lane); continue; } r -= I_BOUT;
        if (r < I_CIN) { transpose_item(p.in[15], NCF, 256, DM, (bf16_t*)(ws + WS_WC_IN), scr, r, lane); continue; } r -= I_CIN;
        if (r < I_COUT) { transpose_item(p.in[17], DM, 64, DM, (bf16_t*)(ws + WS_WC_OUT), scr, r, lane); continue; } r -= I_COUT;
        if (r < I_AIN) { transpose_item(p.in[3] + (size_t)DM * NA, NA, 256, DM, (bf16_t*)(ws + WS_WA_IN + 32 * MiB), scr, r, lane); continue; } r -= I_AIN;
        transpose_item(p.in[5] + (size_t)DM * DM, DM, 64, DM, (bf16_t*)(ws + WS_WA_OUT + 8 * MiB), scr, r, lane);
    }
    for (int it = gw * 64 + lane; it < 2 * 16 * 10 * 5 * 64; it += NGW * 64) { const int l = it & 63, f = it >> 6, ks = f % 5, ct = (f / 5) % 10, nb = (f / 50) % 16, gate = f / 800;
        const float* src = (gate ? p.in[11] : p.in[9]) + (size_t)nb * 25600 + (32 * ks + 8 * (l >> 4)) * 160 + ct * 16 + (l & 15);
        u32x4 o; o.x = pk2(src[0], src[160]); o.y = pk2(src[320], src[480]); o.z = pk2(src[640], src[800]); o.w = pk2(src[960], src[1120]);
        *(u32x4*)(ws + WS_GW + (size_t)it * 16) = o; }
    bf16_t* HB = (bf16_t*)(ws + WS_ACT);
    for (int m = gw; m < MTOK; m += NGW) norm_row_to_bf16(p.in[0] + (size_t)m * DM, p.in[1], HB + (size_t)m * DM, lane);
}

__device__ __forceinline__ void row_phase(const float* Y, const float* xin, float* xout, const float* gpost, const float* gpre, bf16_t* HB,
                                          const float* wf, const float* fbias, float* LOGF, int gw, int NGW, int lane) {
    for (int m = gw; m < MTOK; m += NGW) {
        const f32x4* yr = (const f32x4*)(Y + (size_t)m * DM); const f32x4* xr = (const f32x4*)(xin + (size_t)m * DM); f32x4* orow = (f32x4*)(xout + (size_t)m * DM);
        f32x4 v[8]; float s = 0.f;
#pragma unroll
        for (int j = 0; j < 8; ++j) { v[j] = yr[lane + 64 * j]; s += (v[j].x * v[j].x + v[j].y * v[j].y) + (v[j].z * v[j].z + v[j].w * v[j].w); }
        const float rstd_y = 1.0f / sqrtf(wave_sum(s) * (1.0f / DM) + RMS_EPS);
        float s2 = 0.f;
#pragma unroll
        for (int j = 0; j < 8; ++j) { const f32x4 gg = ((const f32x4*)gpost)[lane + 64 * j]; const f32x4 xx = xr[lane + 64 * j];
            v[j] = xx + v[j] * rstd_y * gg; orow[lane + 64 * j] = v[j];
            s2 += (v[j].x * v[j].x + v[j].y * v[j].y) + (v[j].z * v[j].z + v[j].w * v[j].w); }
        if (gpre) {
            const float rstd = 1.0f / sqrtf(wave_sum(s2) * (1.0f / DM) + RMS_EPS);
#pragma unroll
            for (int j = 0; j < 8; ++j) { const f32x4 gg = ((const f32x4*)gpre)[lane + 64 * j]; v[j] = v[j] * rstd * gg;
                u32x2 w; w.x = pk2(v[j].x, v[j].y); w.y = pk2(v[j].z, v[j].w); ((u32x2*)(HB + (size_t)m * DM))[lane + 64 * j] = w; }
            if (wf) {
                f32x4 a0 = {0.f, 0.f, 0.f, 0.f}, a1 = a0, a2 = a0, a3 = a0;
#pragma unroll
                for (int j = 0; j < 8; ++j)
#pragma unroll
                    for (int e = 0; e < 4; ++e) { const f32x4* wp = (const f32x4*)(wf + (size_t)(4 * lane + 256 * j + e) * NCF); const float hv = v[j][e];
                        a0 += wp[0] * hv; a1 += wp[1] * hv; a2 += wp[2] * hv; a3 += wp[3] * hv; }
                float mine = 0.f;
#pragma unroll
                for (int q = 0; q < 4; ++q) { const float t0 = wave_sum(a0[q]), t1 = wave_sum(a1[q]), t2 = wave_sum(a2[q]), t3 = wave_sum(a3[q]);
                    mine = lane == q ? t0 : mine; mine = lane == 4 + q ? t1 : mine; mine = lane == 8 + q ? t2 : mine; mine = lane == 12 + q ? t3 : mine; }
                if (lane < 16) { const float z = mine + fbias[lane]; const float lf = fminf(z, 0.f) - log1pf(expf(-fabsf(z))); LOGF[(size_t)m * 16 + lane] = lf; }
            }
        }
    }
}

__device__ __forceinline__ void cumsum_phase(const float* LOGF, float* CUMB, LAS float* sc, int G, int blk, int tid) {
    const int lane = tid & 63, wave = tid >> 6;
    for (int bh = blk; bh < NBATCH * NHEAD; bh += G) {
        const int b = bh >> 4, hh = bh & 15; const int t0 = 4 * tid;
        float v[4];
#pragma unroll
        for (int e = 0; e < 4; ++e) v[e] = LOGF[((size_t)(b * SEQ + t0 + e)) * 16 + hh];
        v[1] += v[0]; v[2] += v[1]; v[3] += v[2];
        float incl = v[3];
#pragma unroll
        for (int o = 1; o < 64; o <<= 1) { const float t = __shfl_up(incl, o); if (lane >= o) incl += t; }
        if (lane == 63) sc[wave] = incl;
        __syncthreads();
        float woff = 0.f;
        for (int i = 0; i < wave; ++i) woff += sc[i];
        const float excl = incl - v[3] + woff;
        f32x4 o; o.x = -(excl + v[0]) * LOG2E; o.y = -(excl + v[1]) * LOG2E; o.z = -(excl + v[2]) * LOG2E; o.w = -(excl + v[3]) * LOG2E;
        *(f32x4*)(CUMB + (size_t)bh * SEQ + t0) = o;
        __syncthreads();
    }
}

__device__ __forceinline__ unsigned off_b(unsigned row, unsigned ch) { return 256u * row + 16u * (ch ^ (((row & 3u) << 2) | ((row >> 2) & 3u))); }
#define MFMA32(a, b, c) __builtin_amdgcn_mfma_f32_32x32x16_bf16((a), (b), (c), 0, 0, 0)
template <int MODE>
__device__ __forceinline__ void attn_phase(LAS unsigned char* L, const bf16_t* PROJ, bf16_t* ACT, const float* bias_src, int G, int blk, const int tid) {
    const int  lane = tid & 63, w = __builtin_amdgcn_readfirstlane(tid >> 6), c = lane & 31, hi = lane >> 5;
    LAS float* T = (LAS float*)(L + 65536);
    const int srow = tid >> 4, sch = tid & 15;
    const unsigned soff0 = off_b(srow, sch), soff1 = off_b(srow + 32, sch);
    const unsigned kaddr = 256u * c + 16u * ((unsigned)hi ^ (((c & 3u) << 2) | ((c >> 2) & 3u)));
    const unsigned blk16 = (lane >> 4) & 1, q4 = (lane & 15) >> 2, p4 = lane & 3;
    const unsigned vbase0 = 256u * (4u * hi + q4) + 8u * (p4 & 1u);
    const unsigned vb = 64u * q4 + 16u * (((2u * blk16 + (p4 >> 1)) ^ (unsigned)hi));
    unsigned va[4][2];
#pragma unroll
    for (int db = 0; db < 4; ++db)
#pragma unroll
        for (int t = 0; t < 2; ++t) va[db][t] = vbase0 + (vb ^ (unsigned)(64 * db + 32 * t)) + 2048u * t;
    for (int unit = blk; unit < NBATCH * NHEAD * 8; unit += G) {
        const int bh = unit & 255, qb = unit >> 8, b = bh >> 4, h = bh & 15;
        __syncthreads();
        if (MODE == 0) { for (int i = tid; i < 639; i += 512) { int d = i - 63; d = d < -256 ? -256 : (d > 256 ? 256 : d); T[i] = bias_src[h * NREL + d + 256] * LOG2E; } }
        else { for (int i = tid; i < (qb + 1) * 256; i += 512) T[i] = bias_src[(size_t)bh * SEQ + i]; }
        const int qrow = qb * 256 + w * 32 + c;
        const bf16_t* qp = PROJ + (size_t)(b * SEQ + qrow) * NA + h * HD + 8 * hi;
        bf16x8 qf[8];
#pragma unroll
        for (int s = 0; s < 8; ++s) qf[s] = *(const bf16x8*)(qp + 16 * s);
        const int kt_hi = 4 * qb + 3, kt_lo = MODE == 0 ? (4 * qb - 8 > 0 ? 4 * qb - 8 : 0) : 0;
        const int cw = 4 * qb + (w >> 1);
        const bf16_t* kg = PROJ + (size_t)(b * SEQ + srow) * NA + DM + h * HD + sch * 8;
        u32x4 st0, st1, st2, st3;
        { const bf16_t* g0 = kg + (size_t)kt_lo * 64 * NA;
          st0 = *(const u32x4*)g0; st1 = *(const u32x4*)(g0 + (size_t)32 * NA); st2 = *(const u32x4*)(g0 + DM); st3 = *(const u32x4*)(g0 + (size_t)32 * NA + DM); }
        *(LAS u32x4*)(L + soff0) = st0; *(LAS u32x4*)(L + soff1) = st1; *(LAS u32x4*)(L + 32768 + soff0) = st2; *(LAS u32x4*)(L + 32768 + soff1) = st3;
        f32x16 o0, o1, o2, o3;
#pragma unroll
        for (int r = 0; r < 16; ++r) { o0[r] = 0.f; o1[r] = 0.f; o2[r] = 0.f; o3[r] = 0.f; }
        float mrun = -1e30f, lrun = 0.f;
        __syncthreads();
        int cur = 0;
        for (int kt = kt_lo; kt <= kt_hi; ++kt) {
            const bool more = kt < kt_hi;
            if (more) { const bf16_t* g0 = kg + (size_t)(kt + 1) * 64 * NA;
                st0 = *(const u32x4*)g0; st1 = *(const u32x4*)(g0 + (size_t)32 * NA); st2 = *(const u32x4*)(g0 + DM); st3 = *(const u32x4*)(g0 + (size_t)32 * NA + DM); }
            const bool active = MODE == 0 ? (kt >= cw - 8 && kt <= cw) : (kt <= cw);
            if (active) {
                LAS unsigned char* Kb = L + cur * 16384; LAS unsigned char* Vb = L + 32768 + cur * 16384;
                f32x16 s0, s1;
                if (MODE == 0) { const int base = qrow - kt * 64 + 63 - 4 * hi;
#pragma unroll
                    for (int r = 0; r < 16; ++r) { const int cr = (r & 3) + 8 * (r >> 2); s0[r] = T[base - cr]; s1[r] = T[base - 32 - cr]; } }
                else { const int base = kt * 64 + 4 * hi;
#pragma unroll
                    for (int r = 0; r < 16; ++r) { const int cr = (r & 3) + 8 * (r >> 2); s0[r] = T[base + cr]; s1[r] = T[base + 32 + cr]; } }
#pragma unroll
                for (int s = 0; s < 8; ++s) { const unsigned a = kaddr ^ (unsigned)(s << 5);
                    const bf16x8 k0 = *(const LAS bf16x8*)(Kb + a); const bf16x8 k1 = *(const LAS bf16x8*)(Kb + a + 8192);
                    s0 = MFMA32(k0, qf[s], s0); s1 = MFMA32(k1, qf[s], s1); if (s & 1) __builtin_amdgcn_sched_barrier(0); }
                if (MODE == 1 && kt == cw) {
                    const int rel = qrow - kt * 64 - 4 * hi;
#pragma unroll
                    for (int r = 0; r < 16; ++r) { const int cr = (r & 3) + 8 * (r >> 2);
                        s0[r] = cr <= rel ? s0[r] : -__builtin_inff(); s1[r] = cr + 32 <= rel ? s1[r] : -__builtin_inff(); } }
                float mx = fmaxf(s0[0], s1[0]);
#pragma unroll
                for (int r = 1; r < 16; ++r) mx = fmaxf(mx, fmaxf(s0[r], s1[r]));
                mx = fmaxf(mx, __shfl_xor(mx, 32));
                const float mn = fmaxf(mrun, mx), alpha = __builtin_amdgcn_exp2f(mrun - mn); mrun = mn;
                float ps = 0.f;
#pragma unroll
                for (int r = 0; r < 16; ++r) { s0[r] = __builtin_amdgcn_exp2f(s0[r] - mn); s1[r] = __builtin_amdgcn_exp2f(s1[r] - mn); ps += s0[r] + s1[r]; }
                lrun = lrun * alpha + ps;
                o0 *= alpha; o1 *= alpha; o2 *= alpha; o3 *= alpha;
                bf16x8 pb[4];
#pragma unroll
                for (int ks = 0; ks < 2; ++ks) { u32x4 a, bq;
                    a.x = pk2(s0[8 * ks + 0], s0[8 * ks + 1]); a.y = pk2(s0[8 * ks + 2], s0[8 * ks + 3]); a.z = pk2(s0[8 * ks + 4], s0[8 * ks + 5]); a.w = pk2(s0[8 * ks + 6], s0[8 * ks + 7]);
                    bq.x = pk2(s1[8 * ks + 0], s1[8 * ks + 1]); bq.y = pk2(s1[8 * ks + 2], s1[8 * ks + 3]); bq.z = pk2(s1[8 * ks + 4], s1[8 * ks + 5]); bq.w = pk2(s1[8 * ks + 6], s1[8 * ks + 7]);
                    pb[ks] = __builtin_bit_cast(bf16x8, a); pb[2 + ks] = __builtin_bit_cast(bf16x8, bq); }
#define PV_STEP(OD, DB) _Pragma("unroll") for (int ks = 0; ks < 4; ++ks) { \
                    const s16x4 lo = __builtin_amdgcn_ds_read_tr16_b64_v4i16((LAS s16x4*)(Vb + va[DB][0] + 4096 * ks)); \
                    const s16x4 hh = __builtin_amdgcn_ds_read_tr16_b64_v4i16((LAS s16x4*)(Vb + va[DB][1] + 4096 * ks)); \
                    const bf16x8 vf = __builtin_shufflevector(lo, hh, 0, 1, 2, 3, 4, 5, 6, 7); OD = MFMA32(vf, pb[ks], OD); }
                __builtin_amdgcn_sched_barrier(0); PV_STEP(o0, 0) __builtin_amdgcn_sched_barrier(0); PV_STEP(o1, 1) __builtin_amdgcn_sched_barrier(0); PV_STEP(o2, 2) __builtin_amdgcn_sched_barrier(0); PV_STEP(o3, 3) __builtin_amdgcn_sched_barrier(0);
#undef PV_STEP
            }
            if (more) { LAS unsigned char* Kn = L + (cur ^ 1) * 16384; LAS unsigned char* Vn = L + 32768 + (cur ^ 1) * 16384;
                *(LAS u32x4*)(Kn + soff0) = st0; *(LAS u32x4*)(Kn + soff1) = st1; *(LAS u32x4*)(Vn + soff0) = st2; *(LAS u32x4*)(Vn + soff1) = st3; }
            __syncthreads();
            cur ^= 1;
        }
        lrun += __shfl_xor(lrun, 32);
        const float inv = 1.0f / lrun;
        const bf16_t* gp = PROJ + (size_t)(b * SEQ + qrow) * NA + 3 * DM + h * HD + 4 * hi;
        bf16_t* op = ACT + (size_t)(b * SEQ + qrow) * DM + h * HD + 4 * hi;
#define O_STORE(OD, DB) _Pragma("unroll") for (int g4 = 0; g4 < 4; ++g4) { const u32x2 sg = *(const u32x2*)(gp + 32 * DB + 8 * g4); \
            u32x2 ov; ov.x = pk2(OD[4 * g4 + 0] * inv * bflo(sg.x), OD[4 * g4 + 1] * inv * bfhi(sg.x)); ov.y = pk2(OD[4 * g4 + 2] * inv * bflo(sg.y), OD[4 * g4 + 3] * inv * bfhi(sg.y)); \
            *(u32x2*)(op + 32 * DB + 8 * g4) = ov; }
        O_STORE(o0, 0) O_STORE(o1, 1) O_STORE(o2, 2) O_STORE(o3, 3)
#undef O_STORE
    }
}

#define MFMA16(a, b, c) __builtin_amdgcn_mfma_f32_16x16x32_bf16((a), (b), (c), 0, 0, 0)
constexpr int XC_LD = 168, LA_LD = 164;
__device__ __forceinline__ void rglru_phase(LAS unsigned char* L, const bf16_t* PROJ, bf16_t* ACT, const float* conv_w, const float* conv_b, const bf16x8* GW, const float* gab,
                                            const float* gxb, const float* lam, int G, int blk, const int tid) {
    const int  lane = tid & 63, w = __builtin_amdgcn_readfirstlane(tid >> 6), fr = lane & 15, fq = lane >> 4;
    LAS bf16_t* XC = (LAS bf16_t*)L;
    LAS float* LA = (LAS float*)(L + 21504);
    LAS float* LU = (LAS float*)(L + 21504 + 41984);
    LAS float* CW = (LAS float*)(L + 21504 + 2 * 41984);
    for (int unit = blk; unit < NBATCH * 16; unit += G) {
        const int b = unit >> 4, nb = unit & 15, ch0 = nb * 160;
        __syncthreads();
        for (int i = tid; i < 800; i += 512) { const int j = i / 160, ch = i - j * 160; CW[i] = j < 4 ? conv_w[j * RGW + ch0 + ch] : conv_b[ch0 + ch]; }
        bf16x8 wa0[5], wx0[5], wa1[5], wx1[5];
        const int col0 = w * 16 + fr, col1 = (8 + (w >> 2)) * 16 + fr;
        { const bf16x8* ga0 = GW + ((size_t)((0 * 16 + nb) * 10 + w) * 5) * 64 + lane; const bf16x8* gx0 = GW + ((size_t)((1 * 16 + nb) * 10 + w) * 5) * 64 + lane;
          const bf16x8* ga1 = GW + ((size_t)((0 * 16 + nb) * 10 + 8 + (w >> 2)) * 5) * 64 + lane; const bf16x8* gx1 = GW + ((size_t)((1 * 16 + nb) * 10 + 8 + (w >> 2)) * 5) * 64 + lane;
#pragma unroll
          for (int ks = 0; ks < 5; ++ks) { wa0[ks] = ga0[ks * 64]; wx0[ks] = gx0[ks * 64]; wa1[ks] = ga1[ks * 64]; wx1[ks] = gx1[ks * 64]; } }
        const float ba0 = gab[ch0 + col0], bx0 = gxb[ch0 + col0], ba1 = gab[ch0 + col1], bx1 = gxb[ch0 + col1];
        const float l0 = lam[ch0 + col0], l1 = lam[ch0 + col1];
        const float sp0 = -8.0f * LOG2E * (fmaxf(-l0, 0.f) + log1pf(expf(-fabsf(l0)))), sp1 = -8.0f * LOG2E * (fmaxf(-l1, 0.f) + log1pf(expf(-fabsf(l1))));
        float hstate = 0.f;
        __syncthreads();
        for (int chunk = 0; chunk < SEQ / 64; ++chunk) {
            const int t0 = chunk * 64;
#pragma unroll
            for (int it = 0; it < 5; ++it) { const int i = tid + 512 * it, t = i / 40, c4 = (i - t * 40) * 4;
                f32x4 acc = *(const LAS f32x4*)(CW + 640 + c4);
#pragma unroll
                for (int j = 0; j < 4; ++j) { const int tt = t0 + t - 3 + j;
                    if (tt >= 0) { const u32x2 xv = *(const u32x2*)(PROJ + (size_t)(b * SEQ + tt) * NBP + ch0 + c4); const f32x4 cw4 = *(const LAS f32x4*)(CW + j * 160 + c4);
                        acc.x += bflo(xv.x) * cw4.x; acc.y += bfhi(xv.x) * cw4.y; acc.z += bflo(xv.y) * cw4.z; acc.w += bfhi(xv.y) * cw4.w; } }
                u32x2 o; o.x = pk2(acc.x, acc.y); o.y = pk2(acc.z, acc.w); *(LAS u32x2*)(XC + t * XC_LD + c4) = o; }
            __syncthreads();
#define GATE_TILE(RT, COL, WA, WX, BA, BX, SP) { f32x4 aa = {0.f, 0.f, 0.f, 0.f}, ax = {0.f, 0.f, 0.f, 0.f}; \
                _Pragma("unroll") for (int ks = 0; ks < 5; ++ks) { const bf16x8 af = *(const LAS bf16x8*)(XC + ((RT) * 16 + fr) * XC_LD + 32 * ks + 8 * fq); aa = MFMA16(af, WA[ks], aa); ax = MFMA16(af, WX[ks], ax); } \
                _Pragma("unroll") for (int rg = 0; rg < 4; ++rg) { const int t = (RT) * 16 + fq * 4 + rg; \
                    const float r = fast_sigmoid(aa[rg] + BA), ig = fast_sigmoid(ax[rg] + BX); const float a = __builtin_amdgcn_exp2f(SP * r); \
                    const float xv = __uint_as_float((unsigned)XC[t * XC_LD + (COL)] << 16); const float u = sqrtf(fmaxf(1.0f - a * a, 0.f)) * ig * xv; \
                    LA[t * LA_LD + (COL)] = a; LU[t * LA_LD + (COL)] = u; } }
#pragma unroll
            for (int rt = 0; rt < 4; ++rt) GATE_TILE(rt, col0, wa0, wx0, ba0, bx0, sp0)
            GATE_TILE((w & 3), col1, wa1, wx1, ba1, bx1, sp1)
#undef GATE_TILE
            __syncthreads();
            if (tid < 160) {
#pragma unroll 8
                for (int t = 0; t < 64; ++t) { hstate = LA[t * LA_LD + tid] * hstate + LU[t * LA_LD + tid]; LU[t * LA_LD + tid] = hstate; }
            }
            __syncthreads();
#pragma unroll
            for (int it = 0; it < 5; ++it) { const int i = tid + 512 * it, t = i / 40, c4 = (i - t * 40) * 4;
                const f32x4 hv = *(const LAS f32x4*)(LU + t * LA_LD + c4);
                const u32x2 sg = *(const u32x2*)(PROJ + (size_t)(b * SEQ + t0 + t) * NBP + RGW + ch0 + c4);
                u32x2 o; o.x = pk2(hv.x * bflo(sg.x), hv.y * bfhi(sg.x)); o.y = pk2(hv.z * bflo(sg.y), hv.w * bfhi(sg.y));
                *(u32x2*)(ACT + (size_t)(b * SEQ + t0 + t) * RGW + ch0 + c4) = o; }
        }
    }
}

#define XB_TMO      128
#define XB_XCNT(j)  (256  + 64 * (j))
#define XB_XSUB(j)  (1280 + 64 * (j))
#define XB_XGEN(j)  (2304 + 64 * (j))
#define XB_TOP      3328
#define XB_TOPGEN   3392
#define XCD_BAR_WORDS 3456
#define XB_SPIN_CAP (1u << 18)

__device__ __forceinline__ unsigned xb_ld(unsigned* p)              { return __hip_atomic_load(p, __ATOMIC_RELAXED, __HIP_MEMORY_SCOPE_AGENT); }
__device__ __forceinline__ unsigned xb_add(unsigned* p, unsigned v) { return __hip_atomic_fetch_add(p, v, __ATOMIC_RELAXED, __HIP_MEMORY_SCOPE_AGENT); }
__device__ __forceinline__ unsigned xb_xcc_id() { return (unsigned)__builtin_amdgcn_s_getreg((3 << 11) | 20) & 0xFu; }
#define XB_SPIN(cond, bar) do { unsigned _sp = 0; while (cond) { __builtin_amdgcn_s_sleep(1); \
    if ((++_sp & 255u) == 0u) { if (xb_ld(&(bar)[XB_TMO])) break; if (_sp > XB_SPIN_CAP) { atomicAdd(&(bar)[XB_TMO], 1u); break; } } } } while (0)

struct XcdBarrier {
    unsigned* bar; unsigned x;
    volatile LAS unsigned* st;
};

__device__ __forceinline__ XcdBarrier xcd_barrier_post(unsigned* bar, volatile LAS unsigned* st) {
    XcdBarrier b; b.bar = bar; b.x = xb_xcc_id(); b.st = st;
    if (threadIdx.x == 0) (void)xb_add(&bar[XB_XCNT(b.x)], 1u);
    return b;
}
__device__ __forceinline__ void xcd_barrier_complete(unsigned* bar, unsigned x, unsigned& nloc, unsigned& nx) {
    const unsigned G = gridDim.x * gridDim.y * gridDim.z;
    unsigned sum, cnt, mine, sp = 0u;
    for (;;) {
        sum = 0u; cnt = 0u; mine = 0u;
#pragma unroll
        for (unsigned j = 0; j < 16; ++j) { const unsigned c = xb_ld(&bar[XB_XCNT(j)]); sum += c; cnt += (c > 0u) ? 1u : 0u; mine = (j == x) ? c : mine; }
        if (sum == G) break;
        __builtin_amdgcn_s_sleep(1);
        if ((++sp & 255u) == 0u) { if (xb_ld(&bar[XB_TMO])) break; if (sp > XB_SPIN_CAP) { atomicAdd(&bar[XB_TMO], 1u); break; } }
    }
    nloc = mine > 0u ? mine : 1u; nx = cnt > 0u ? cnt : 1u;
}

__device__ __forceinline__ void xcd_barrier(const XcdBarrier& b) {
    asm volatile("s_waitcnt vmcnt(0)" ::: "memory");
    __syncthreads();
    if (threadIdx.x == 0) {
        unsigned* bar = b.bar;
        __builtin_amdgcn_s_waitcnt(0);
        unsigned nloc = b.st[0], nx = b.st[1];
        if (nloc == 0u) { xcd_barrier_complete(bar, b.x, nloc, nx); b.st[0] = nloc; b.st[1] = nx; }
        const unsigned old = xb_add(&bar[XB_XSUB(b.x)], 1u);
        const unsigned gen = old / nloc;
        if (old + 1u == (gen + 1u) * nloc) {
            __builtin_amdgcn_fence(__ATOMIC_RELEASE, "agent");
            asm volatile("s_waitcnt vmcnt(0)" ::: "memory");
            const unsigned og = xb_add(&bar[XB_TOP], 1u);
            const unsigned tg = og / nx;
            if (og + 1u == (tg + 1u) * nx) xb_add(&bar[XB_TOPGEN], 1u);
            else XB_SPIN(xb_ld(&bar[XB_TOPGEN]) == tg, bar);
            __builtin_amdgcn_fence(__ATOMIC_ACQUIRE, "agent");
            xb_add(&bar[XB_XGEN(b.x)], 1u);
            asm volatile("s_waitcnt vmcnt(0)" ::: "memory");
        } else {
            XB_SPIN(xb_ld(&bar[XB_XGEN(b.x)]) == gen, bar);
            __builtin_amdgcn_fence(__ATOMIC_ACQUIRE, "agent");
            asm volatile("s_waitcnt vmcnt(0)" ::: "memory");
        }
    }
    __syncthreads();
}

#ifndef MK_LAUNCHES
#define MK_LAUNCHES 1
#endif
#ifndef PROBE_REPEAT_MASK
#define PROBE_REPEAT_MASK 0x0
#endif
__global__ void __launch_bounds__(512, 2) hybrid_trunk_mega(Params p) {
    extern __shared__ __attribute__((aligned(16))) unsigned char lds_raw[];
    LAS unsigned char* L = (LAS unsigned char*)lds_raw;
    cg::grid_group grid = cg::this_grid();
    if (threadIdx.x < 4) ((LAS unsigned*)(L + LDS_BYTES - 16))[threadIdx.x] = 0u;
    __syncthreads();
    XcdBarrier xbar = xcd_barrier_post((unsigned*)(p.ws + WS_BAR), (volatile LAS unsigned*)(L + LDS_BYTES - 16));
    const int G = gridDim.x, blk = blockIdx.x;
    unsigned char* ws = p.ws;
    bf16_t* ACT = (bf16_t*)(ws + WS_ACT); bf16_t* PROJ = (bf16_t*)(ws + WS_PROJ); float* Y = (float*)(ws + WS_PROJ);
    float* LOGF = (float*)(ws + WS_LOGF); float* CUMB = (float*)(ws + WS_CUMB);
    for (int ph = p.ph_lo; ph < p.ph_hi; ++ph) {
      for (int rep = 0; rep < (((PROBE_REPEAT_MASK) >> ph) & 1) + 1; ++rep) {
        int tid = threadIdx.x; asm volatile("" : "+v"(tid));
        const int lane = tid & 63, wave = __builtin_amdgcn_readfirstlane(tid >> 6);
        if (ph == 0) {
#ifndef SKIP_PRO
            prologue_phase(p, L, G, blk, wave, lane);
#endif
        }
        else {
            const int layer = (ph - 1) >> 2, sub = (ph - 1) & 3, mix = layer % 3, j = layer / 3;
            if (sub == 0) {
                const bf16_t* Wt = mix == 0 ? (const bf16_t*)(ws + WS_WA_IN + (size_t)j * 32 * MiB) : mix == 1 ? (const bf16_t*)(ws + WS_WB_IN) : (const bf16_t*)(ws + WS_WC_IN);
                const int N = mix == 1 ? NBP : NA;
                if (mix == 2) cumsum_phase(LOGF, CUMB, (LAS float*)L, G, blk, tid);
                pg8::Gemm g{ACT, Wt, MTOK, N, DM}; pg8::StaticOrder S; S.init(MTOK, N, G, blk);
                pg8::EpiProj E{PROJ, N, mix == 1 ? 0 : DM, QSCALE, mix == 1 ? RGW : 3 * DM};
#ifndef SKIP_GEMM1
                pg8::gemm_phase<pg8::EpiProj, pg8::StaticOrder>(L, g, S, E, tid);
#endif
            } else if (sub == 1) {
#ifndef SKIP_ATTN0
                if (mix == 0) attn_phase<0>(L, PROJ, ACT, p.in[4] + (size_t)j * NHEAD * NREL, G, blk, tid);
#endif
#ifndef SKIP_RGLRU
                if (mix == 1) rglru_phase(L, PROJ, ACT, p.in[7], p.in[8], (const bf16x8*)(ws + WS_GW), p.in[10], p.in[12], p.in[13], G, blk, tid);
#endif
#ifndef SKIP_ATTN1
                if (mix == 2) attn_phase<1>(L, PROJ, ACT, CUMB, G, blk, tid);
#endif
            } else if (sub == 2) {
                const bf16_t* Wt = mix == 0 ? (const bf16_t*)(ws + WS_WA_OUT + (size_t)j * 8 * MiB) : mix == 1 ? (const bf16_t*)(ws + WS_WB_OUT) : (const bf16_t*)(ws + WS_WC_OUT);
                const int K = mix == 1 ? RGW : DM;
                pg8::Gemm g{ACT, Wt, MTOK, DM, K}; pg8::StaticOrder S; S.init(MTOK, DM, G, blk);
                pg8::EpiF32 E{Y, DM, nullptr};
#ifndef SKIP_GEMM2
                pg8::gemm_phase<pg8::EpiF32, pg8::StaticOrder>(L, g, S, E, tid);
#endif
            } else {
                const float* xin = layer == 0 ? p.in[0] : p.out;
                const float* gpre = layer < 3 ? p.in[1] + (size_t)(layer + 1) * DM : nullptr;
                const float* wf = (layer + 1) % 3 == 2 && layer < 3 ? p.in[15] + 4 * DM : nullptr;
#ifndef SKIP_ROW
                row_phase(Y, xin, p.out, p.in[2] + (size_t)layer * DM, gpre, ACT, wf, p.in[16], LOGF, blk * 8 + wave, G * 8, lane);
#endif
            }
        }
      }
        if (ph + 1 < p.ph_hi) { if (ph == p.ph_lo) grid.sync(); else xcd_barrier(xbar); }
    }
}

extern "C" void kernel_launch(void* const* d_in, const int* in_sizes, int n_in, void* d_out, int out_size, void* d_ws, size_t ws_size, hipStream_t stream) {
    static int grid = 0;
    if (grid == 0) {
        if (n_in != 18 || in_sizes[0] != MTOK * DM || out_size != MTOK * DM || ws_size < WS_END) {
            fprintf(stderr, "kernel_launch: unexpected shapes (n_in %d, in0 %d, out %d, ws %zu; need ws >= %zu)\n", n_in, n_in > 0 ? in_sizes[0] : -1, out_size, ws_size, (size_t)WS_END); grid = -1; return; }
        int dev = 0, cus = 0, per_cu = 0;
        (void)hipGetDevice(&dev); (void)hipDeviceGetAttribute(&cus, hipDeviceAttributeMultiprocessorCount, dev);
        if (hipFuncSetAttribute((const void*)hybrid_trunk_mega, hipFuncAttributeMaxDynamicSharedMemorySize, LDS_BYTES) != hipSuccess) { fprintf(stderr, "kernel_launch: hipFuncSetAttribute failed\n"); grid = -1; return; }
        if (hipOccupancyMaxActiveBlocksPerMultiprocessor(&per_cu, (const void*)hybrid_trunk_mega, 512, LDS_BYTES) != hipSuccess || per_cu < 1) { fprintf(stderr, "kernel_launch: occupancy query gave %d\n", per_cu); per_cu = 1; }
        (void)hipGetLastError();
        grid = cus * per_cu;
    }
    if (grid < 0) return;
    if (hipMemsetAsync((char*)d_ws + WS_BAR, 0, 16384, stream) != hipSuccess) { fprintf(stderr, "kernel_launch: memset of the barrier words failed\n"); return; }
    Params p{};
    for (int i = 0; i < 18; ++i) p.in[i] = (const float*)d_in[i];
    p.out = (float*)d_out; p.ws = (unsigned char*)d_ws;
#if MK_LAUNCHES == 1
    p.ph_lo = 0; p.ph_hi = NPHASE;
    void* args[] = {&p};
    const hipError_t e = hipLaunchCooperativeKernel((const void*)hybrid_trunk_mega, dim3(grid), dim3(512), args, LDS_BYTES, stream);
    if (e != hipSuccess) fprintf(stderr, "kernel_launch: cooperative launch failed: %s (grid %d)\n", hipGetErrorString(e), grid);
#else
    for (int ph = 0; ph < NPHASE; ++ph) { p.ph_lo = ph; p.ph_hi = ph + 1; hipLaunchKernelGGL(hybrid_trunk_mega, dim3(grid), dim3(512), LDS_BYTES, stream, p); }
#endif
}
```

```cpp
#include <hip/hip_runtime.h>
#include <hip/hip_cooperative_groups.h>
#include <cstdio>
#include <cstdint>
namespace cg = cooperative_groups;
namespace pg8 {
#define PG8_LAS __attribute__((address_space(3)))
typedef unsigned short bf16_t;
typedef short bf16x8 __attribute__((ext_vector_type(8)));
typedef float f32x4 __attribute__((ext_vector_type(4)));
typedef unsigned u32x4 __attribute__((ext_vector_type(4)));
constexpr int BM = 256, BK = 64, HALF = 128, HTB = HALF * BK * 2  , STAGE_BYTES = 8 * HTB, NXCD = 8, WGM = 8;

__host__ __device__ __forceinline__ int lds_byte(int r, int c) { const int st = (r >> 4) * 2 + (c >> 5), rr = r & 15, cc = c & 31, ob = rr * 64 + cc * 2; return st * 1024 + (ob ^ (((ob >> 9) & 1) << 5)); }
__host__ __device__ __forceinline__ void stage_rc(int b, int& R, int& C) { const int st = b / 1024, sb = b % 1024, swz = sb ^ (((sb >> 9) & 1) << 5); R = (st >> 1) * 16 + swz / 64; C = (st & 1) * 32 + (swz % 64) / 2; }
__host__ __device__ __forceinline__ int perm32(int rho) { const int n = rho >> 4, i = rho & 15; return 8 * (i >> 2) + 4 * n + (i & 3); }

struct Unit { int pm, pn; };
struct Gemm { const bf16_t* A; const bf16_t* Bt; int M, N, K; };

struct StaticOrder {
    int nM, nN, nwg, G, c;
    __host__ __device__ void init(int M, int N, int G_, int c_) { nM = M / BM; nN = N / BM; nwg = nM * nN; G = G_; c = c_; }
    __host__ __device__ bool next(int i, Unit& u) const {
        const long L = (long)i * G + c; if (L >= nwg) return false;
        int wgid = (int)L; { const int q = nwg / NXCD, r = nwg % NXCD, xcd = wgid % NXCD, off = wgid / NXCD; wgid = (xcd < r ? xcd * (q + 1) : r * (q + 1) + (xcd - r) * q) + off; }
        const int nig = WGM * nN, gid = wgid / nig, fm = gid * WGM, gsz = (nM - fm) < WGM ? (nM - fm) : WGM;
        u.pm = fm + ((wgid % nig) % gsz); u.pn = (wgid % nig) / gsz; return true;
    }
    __device__ __forceinline__ void a_ready(const Unit&) const {}
    __device__ __forceinline__ void done(const Unit&) const {}
};
__device__ __forceinline__ unsigned cvt_pk_bf16(float lo, float hi) { unsigned r; asm volatile("v_cvt_pk_bf16_f32 %0, %1, %2" : "=v"(r) : "v"(lo), "v"(hi)); return r; }
typedef float f32x2 __attribute__((ext_vector_type(2)));
struct EpiF32 {
    static constexpr bool PERM = false, AFTER_DRAIN = false;
    float* C; int ldc; const float* bias;
    __device__ __forceinline__ void operator()(const f32x4 (&acc)[2][2][4][2], const Unit& u, int wr, int wc, int fr, int fq) const {
        const int row0 = u.pm * BM + wr * 64 + fr, col0 = u.pn * BM + wc * 32 + 4 * fq;
        f32x4 bv[2][2];
#pragma unroll
        for (int bj = 0; bj < 2; ++bj)
#pragma unroll
            for (int n = 0; n < 2; ++n) bv[bj][n] = bias ? *(const f32x4*)(bias + col0 + bj * HALF + n * 16) : (f32x4){0.f, 0.f, 0.f, 0.f};
#pragma unroll
        for (int ai = 0; ai < 2; ++ai)
#pragma unroll
            for (int m = 0; m < 4; ++m) { float* rowp = C + (size_t)(row0 + ai * HALF + m * 16) * ldc + col0;
#pragma unroll
                for (int bj = 0; bj < 2; ++bj)
#pragma unroll
                    for (int n = 0; n < 2; ++n) *(f32x4*)(rowp + bj * HALF + n * 16) = acc[ai][bj][m][n] + bv[bj][n]; }
    }
};
template <class Epi, class Sched>
__device__ __forceinline__ void gemm_phase(PG8_LAS unsigned char* lds, const Gemm g, const Sched& S, const Epi& E, const int tid_in) {
    const int tid = tid_in, wid = __builtin_amdgcn_readfirstlane(tid >> 6), lane = tid & 63, wr = wid >> 2, wc = wid & 3, fr = lane & 15, fq = lane >> 4;
    const int K = g.K, nt = K / BK;
    unsigned voffA[2], voffB[2];
#pragma unroll
    for (int i = 0; i < 2; ++i) { int R, C; stage_rc(tid * 16 + i * 8192, R, C); const int Rb = Epi::PERM ? ((R & ~31) + perm32(R & 31)) : R;
        voffA[i] = (unsigned)(R * K + C) * 2u; voffB[i] = (unsigned)(Rb * K + C) * 2u; }
    const size_t kstep = (size_t)(BK * 2);
    const size_t hstep = (size_t)HALF * K * 2;
    const size_t tstep = 2 * hstep;
    const unsigned ldsw = (unsigned)wid * 1024u;
    const int aoff = lds_byte(wr * 64 + fr, fq * 8), boff = lds_byte(wc * 32 + fr, fq * 8);
#define PG8_SA(b, h) (((b) * 2 + (h)) * HTB)
#define PG8_SB(b, h) ((4 + (b) * 2 + (h)) * HTB)
#define PG8_STAGE(bufoff, gbase, voff) do { _Pragma("unroll") for (int _i = 0; _i < 2; ++_i) \
        __builtin_amdgcn_global_load_lds((const unsigned*)((const char*)(gbase) + (voff)[_i]), (PG8_LAS unsigned*)(lds + (bufoff) + ldsw + _i * 8192), 16, 0, 0); } while (0)
#define PG8_LDA(dst, b, h) do { _Pragma("unroll") for (int m = 0; m < 4; ++m) _Pragma("unroll") for (int k = 0; k < 2; ++k) dst[m][k] = *(const PG8_LAS bf16x8*)(lds + PG8_SA(b, h) + aoff + m * 2048 + k * 1024); } while (0)
#define PG8_LDB(dst, b, h) do { _Pragma("unroll") for (int n = 0; n < 2; ++n) _Pragma("unroll") for (int k = 0; k < 2; ++k) dst[n][k] = *(const PG8_LAS bf16x8*)(lds + PG8_SB(b, h) + boff + n * 2048 + k * 1024); } while (0)
#define PG8_MMA(ai, bj, At, Bt) do { __builtin_amdgcn_s_setprio(1); _Pragma("unroll") for (int m = 0; m < 4; ++m) _Pragma("unroll") for (int n = 0; n < 2; ++n) _Pragma("unroll") for (int k = 0; k < 2; ++k) \
        acc[ai][bj][m][n] = __builtin_amdgcn_mfma_f32_16x16x32_bf16(Bt[n][k], At[m][k], acc[ai][bj][m][n], 0, 0, 0); __builtin_amdgcn_s_setprio(0); } while (0)
#define PG8_WAIT_V(n) asm volatile("s_waitcnt vmcnt(" #n ")" ::: "memory")
#define PG8_WAIT_L(n) asm volatile("s_waitcnt lgkmcnt(" #n ")" ::: "memory")
#define PG8_BAR __builtin_amdgcn_s_barrier()
#define PG8_SCHED __builtin_amdgcn_sched_barrier(0)
    Unit cur, nxt; int ui = 0;
    if (!S.next(0, cur)) return;
    f32x4 acc[2][2][4][2];
#pragma unroll
    for (int a = 0; a < 2; ++a)
#pragma unroll
        for (int b = 0; b < 2; ++b)
#pragma unroll
            for (int m = 0; m < 4; ++m)
#pragma unroll
                for (int n = 0; n < 2; ++n) acc[a][b][m][n] = (f32x4){0.f, 0.f, 0.f, 0.f};
    bf16x8 At[4][2], B0[2][2], B1[2][2];
    const char* cA = (const char*)g.A + (size_t)cur.pm * tstep; const char* cB = (const char*)g.Bt + (size_t)cur.pn * tstep;
    S.a_ready(cur);
    PG8_STAGE(PG8_SB(0, 0), cB, voffB); PG8_STAGE(PG8_SA(0, 0), cA, voffA); PG8_STAGE(PG8_SB(0, 1), cB + hstep, voffB); PG8_STAGE(PG8_SA(0, 1), cA + hstep, voffA);
    if (wr == 1) PG8_BAR;
    PG8_WAIT_V(4); PG8_BAR;
    PG8_STAGE(PG8_SB(1, 0), cB + kstep, voffB); PG8_STAGE(PG8_SA(1, 0), cA + kstep, voffA); PG8_STAGE(PG8_SB(1, 1), cB + hstep + kstep, voffB);
    PG8_WAIT_V(6); PG8_BAR;
    for (;;) {
        const bool has_next = S.next(ui + 1, nxt);
        const char* nA = has_next ? (const char*)g.A + (size_t)nxt.pm * tstep : cA; const char* nB = has_next ? (const char*)g.Bt + (size_t)nxt.pn * tstep : cB;
        for (int t = 0; t < nt; t += 2) {
            const bool last = (t == nt - 2);
            const char* a1 = cA + (size_t)(t + 1) * kstep;
            const char* a2 = last ? nA : cA + (size_t)(t + 2) * kstep; const char* b2 = last ? nB : cB + (size_t)(t + 2) * kstep;
            const char* a3 = a2 + kstep; const char* b3 = b2 + kstep;
            if (last && has_next) S.a_ready(nxt);
            PG8_LDB(B0, 0, 0); PG8_SCHED; PG8_LDA(At, 0, 0); PG8_STAGE(PG8_SA(1, 1), a1 + hstep, voffA);
            PG8_WAIT_L(8); PG8_BAR; PG8_WAIT_L(0); PG8_MMA(0, 0, At, B0); PG8_BAR; PG8_SCHED;
            PG8_LDB(B1, 0, 1); PG8_STAGE(PG8_SB(0, 0), b2, voffB);
            PG8_BAR; PG8_WAIT_L(0); PG8_MMA(0, 1, At, B1); PG8_BAR;
            PG8_LDA(At, 0, 1); PG8_STAGE(PG8_SA(0, 0), a2, voffA);
            PG8_BAR; PG8_WAIT_L(0); PG8_MMA(1, 0, At, B0); PG8_BAR; PG8_SCHED;
            PG8_STAGE(PG8_SB(0, 1), b2 + hstep, voffB);
            PG8_WAIT_V(6); PG8_BAR; PG8_MMA(1, 1, At, B1); PG8_BAR;
            PG8_LDB(B0, 1, 0); PG8_SCHED; PG8_LDA(At, 1, 0); PG8_STAGE(PG8_SA(0, 1), a2 + hstep, voffA);
            PG8_WAIT_L(8); PG8_BAR; PG8_WAIT_L(0); PG8_MMA(0, 0, At, B0); PG8_BAR; PG8_SCHED;
            PG8_LDB(B1, 1, 1); PG8_STAGE(PG8_SB(1, 0), b3, voffB);
            PG8_BAR; PG8_WAIT_L(0); PG8_MMA(0, 1, At, B1); PG8_BAR;
            PG8_LDA(At, 1, 1); PG8_STAGE(PG8_SA(1, 0), a3, voffA);
            PG8_BAR; PG8_WAIT_L(0); PG8_MMA(1, 0, At, B0); PG8_BAR; PG8_SCHED;
            PG8_STAGE(PG8_SB(1, 1), b3 + hstep, voffB);
            PG8_WAIT_V(6); PG8_BAR; PG8_MMA(1, 1, At, B1); PG8_BAR;
        }
        if constexpr (!Epi::AFTER_DRAIN) { E(acc, cur, wr, wc, fr, fq); S.done(cur); }
        if (!has_next) break;
#pragma unroll
        for (int a = 0; a < 2; ++a)
#pragma unroll
            for (int b = 0; b < 2; ++b)
#pragma unroll
                for (int m = 0; m < 4; ++m)
#pragma unroll
                    for (int n = 0; n < 2; ++n) acc[a][b][m][n] = (f32x4){0.f, 0.f, 0.f, 0.f};
        cur = nxt; cA = nA; cB = nB; ++ui;
    }
    PG8_WAIT_V(0);
    if (wr == 0) PG8_BAR;
    PG8_BAR;
    if constexpr (Epi::AFTER_DRAIN) { E.fused(acc, cur, wr, wc, fr, fq, lds, wid, lane); S.done(cur); }
#undef PG8_SA
#undef PG8_SB
#undef PG8_STAGE
#undef PG8_LDA
#undef PG8_LDB
#undef PG8_MMA
#undef PG8_WAIT_V
#undef PG8_WAIT_L
#undef PG8_BAR
#undef PG8_SCHED
}
}

#define LAS __attribute__((address_space(3)))
typedef unsigned short bf16_t;
typedef short bf16x8 __attribute__((ext_vector_type(8)));
typedef short s16x4 __attribute__((ext_vector_type(4)));
typedef float f32x4 __attribute__((ext_vector_type(4)));
typedef float f32x2 __attribute__((ext_vector_type(2)));
typedef float f32x16 __attribute__((ext_vector_type(16)));
typedef unsigned u32x4 __attribute__((ext_vector_type(4)));
typedef unsigned u32x2 __attribute__((ext_vector_type(2)));
typedef __bf16 bf16v2 __attribute__((ext_vector_type(2)));

constexpr int DM = 2048, SEQ = 2048, NBATCH = 16, MTOK = NBATCH * SEQ;
constexpr int NHEAD = 16, HD = 128;
constexpr int NA = 8192, NBP = 5120, RGW = 2560, NCF = 8208, NREL = 513;
constexpr float RMS_EPS = 1e-6f, LOG2E = 1.4426950408889634f;
constexpr float QSCALE = 0.08838834764831845f * 1.4426950408889634f;
constexpr size_t MiB = (size_t)1 << 20;
constexpr size_t WS_WA_IN = 0, WS_WA_OUT = 64 * MiB, WS_WB_IN = 80 * MiB, WS_WB_OUT = 100 * MiB, WS_WC_IN = 110 * MiB, WS_WC_OUT = 142 * MiB;
constexpr size_t WS_LOGF = 150 * MiB, WS_CUMB = 152 * MiB, WS_GW = 154 * MiB, WS_BAR = 158 * MiB, WS_ACT = 160 * MiB, WS_PROJ = 320 * MiB, WS_END = 832 * MiB;
constexpr int LDS_BYTES = 147456;
constexpr int NPHASE = 17;

struct Params { const float* in[18]; float* out; unsigned char* ws; int ph_lo, ph_hi; };

__device__ __forceinline__ unsigned pk2(float a, float b) { const bf16v2 v = __builtin_convertvector((f32x2){a, b}, bf16v2); return __builtin_bit_cast(unsigned, v); }
__device__ __forceinline__ float bflo(unsigned w) { return __uint_as_float(w << 16); }
__device__ __forceinline__ float bfhi(unsigned w) { return __uint_as_float(w & 0xffff0000u); }
__device__ __forceinline__ float wave_sum(float v) {
#pragma unroll
    for (int o = 1; o < 64; o <<= 1) v += __shfl_xor(v, o);
    return v;
}
__device__ __forceinline__ float fast_sigmoid(float z) { return __builtin_amdgcn_rcpf(1.0f + __builtin_amdgcn_exp2f(-LOG2E * z)); }

namespace pg8 {
struct EpiProj {
    static constexpr bool PERM = true, AFTER_DRAIN = false;
    bf16_t* O; int ldc; int q_end; float qscale; int g_begin;
    __device__ __forceinline__ void operator()(const f32x4 (&acc)[2][2][4][2], const Unit& u, int wr, int wc, int fr, int fq) const {
        const int row0 = u.pm * BM + wr * 64 + fr; const int colt = u.pn * BM;
        const int col0 = colt + wc * 32 + 8 * fq;
        const bool is_g = colt >= g_begin; const float sc = colt < q_end ? qscale : 1.0f;
#pragma unroll
        for (int ai = 0; ai < 2; ++ai)
#pragma unroll
            for (int m = 0; m < 4; ++m) { bf16_t* rowp = O + (size_t)(row0 + ai * HALF + m * 16) * ldc + col0;
#pragma unroll
                for (int bj = 0; bj < 2; ++bj) { f32x4 v0 = acc[ai][bj][m][0] * sc, v1 = acc[ai][bj][m][1] * sc;
                    if (is_g) {
#pragma unroll
                        for (int j = 0; j < 4; ++j) { v0[j] = v0[j] * __builtin_amdgcn_rcpf(1.0f + __builtin_amdgcn_exp2f(-1.4426950408889634f * v0[j])); v1[j] = v1[j] * __builtin_amdgcn_rcpf(1.0f + __builtin_amdgcn_exp2f(-1.4426950408889634f * v1[j])); } }
                    u32x4 w; w.x = cvt_pk_bf16(v0[0], v0[1]); w.y = cvt_pk_bf16(v0[2], v0[3]); w.z = cvt_pk_bf16(v1[0], v1[1]); w.w = cvt_pk_bf16(v1[2], v1[3]);
                    *(u32x4*)(rowp + bj * HALF) = w; } }
    }
};
}

__device__ __forceinline__ void transpose_item(const float* W, int ldw, int nblk, int K, bf16_t* WT, LAS float* scr, int item, int lane) {
    const int kb = item / nblk, nb = item - kb * nblk, k0 = 64 * kb, n0 = 32 * nb;
#pragma unroll 8
    for (int i = 0; i < 32; ++i) { const int kk = 2 * i + (lane >> 5); scr[kk * 33 + (lane & 31)] = W[(size_t)(k0 + kk) * ldw + n0 + (lane & 31)]; }
    asm volatile("s_waitcnt lgkmcnt(0)" ::: "memory");
    const int c = lane & 7;
#pragma unroll
    for (int j = 0; j < 4; ++j) { const int n = (lane >> 3) + 8 * j; const LAS float* s = scr + (8 * c) * 33 + n;
        u32x4 o; o.x = pk2(s[0 * 33], s[1 * 33]); o.y = pk2(s[2 * 33], s[3 * 33]); o.z = pk2(s[4 * 33], s[5 * 33]); o.w = pk2(s[6 * 33], s[7 * 33]);
        *(u32x4*)(WT + (size_t)(n0 + n) * K + k0 + 8 * c) = o; }
    asm volatile("s_waitcnt lgkmcnt(0)" ::: "memory");
}
__device__ __forceinline__ void norm_row_to_bf16(const float* xrow, const float* g, bf16_t* orow, int lane) {
    f32x4 v[8]; float s = 0.f;
#pragma unroll
    for (int j = 0; j < 8; ++j) { v[j] = ((const f32x4*)xrow)[lane + 64 * j]; s += (v[j].x * v[j].x + v[j].y * v[j].y) + (v[j].z * v[j].z + v[j].w * v[j].w); }
    const float rstd = 1.0f / sqrtf(wave_sum(s) * (1.0f / DM) + RMS_EPS);
#pragma unroll
    for (int j = 0; j < 8; ++j) { const f32x4 gg = ((const f32x4*)g)[lane + 64 * j]; const f32x4 o = v[j] * rstd * gg;
        u32x2 w; w.x = pk2(o.x, o.y); w.y = pk2(o.z, o.w); ((u32x2*)orow)[lane + 64 * j] = w; }
}
__device__ __forceinline__ void prologue_phase(const Params& p, LAS unsigned char* L, int G, int blk, int wave, int lane) {
    LAS float* scr = (LAS float*)(L + wave * 16384);
    const int gw = blk * 8 + wave, NGW = G * 8;
    unsigned char* ws = p.ws;
    constexpr int I_AIN = 32 * 256, I_AOUT = 32 * 64, I_BIN = 32 * 160, I_BOUT = 40 * 64, I_CIN = 32 * 256, I_COUT = 32 * 64;
    constexpr int NITEMS = 2 * I_AIN + 2 * I_AOUT + I_BIN + I_BOUT + I_CIN + I_COUT;
    for (int it = gw; it < NITEMS; it += NGW) {
        int r = it;
        if (r < I_AIN) { transpose_item(p.in[3], NA, 256, DM, (bf16_t*)(ws + WS_WA_IN), scr, r, lane); continue; } r -= I_AIN;
        if (r < I_AOUT) { transpose_item(p.in[5], DM, 64, DM, (bf16_t*)(ws + WS_WA_OUT), scr, r, lane); continue; } r -= I_AOUT;
        if (r < I_BIN) { transpose_item(p.in[6], NBP, 160, DM, (bf16_t*)(ws + WS_WB_IN), scr, r, lane); continue; } r -= I_BIN;
        if (r < I_BOUT) { transpose_item(p.in[14], DM, 64, RGW, (bf16_t*)(ws + WS_WB_OUT), scr, r, lane); continue; } r -= I_BOUT;
        if (r < I_CIN) { transpose_item(p.in[15], NCF, 256, DM, (bf16_t*)(ws + WS_WC_IN), scr, r, lane); continue; } r -= I_CIN;
        if (r < I_COUT) { transpose_item(p.in[17], DM, 64, DM, (bf16_t*)(ws + WS_WC_OUT), scr, r, lane); continue; } r -= I_COUT;
        if (r < I_AIN) { transpose_item(p.in[3] + (size_t)DM * NA, NA, 256, DM, (bf16_t*)(ws + WS_WA_IN + 32 * MiB), scr, r, lane); continue; } r -= I_AIN;
        transpose_item(p.in[5] + (size_t)DM * DM, DM, 64, DM, (bf16_t*)(ws + WS_WA_OUT + 8 * MiB), scr, r, lane);
    }
    for (int it = gw * 64 + lane; it < 2 * 16 * 10 * 5 * 64; it += NGW * 64) { const int l = it & 63, f = it >> 6, ks = f % 5, ct = (f / 5) % 10, nb = (f / 50) % 16, gate = f / 800;
        const float* src = (gate ? p.in[11] : p.in[9]) + (size_t)nb * 25600 + (32 * ks + 8 * (l >> 4)) * 160 + ct * 16 + (l & 15);
        u32x4 o; o.x = pk2(src[0], src[160]); o.y = pk2(src[320], src[480]); o.z = pk2(src[640], src[800]); o.w = pk2(src[960], src[1120]);
        *(u32x4*)(ws + WS_GW + (size_t)it * 16) = o; }
    bf16_t* HB = (bf16_t*)(ws + WS_ACT);
    for (int m = gw; m < MTOK; m += NGW) norm_row_to_bf16(p.in[0] + (size_t)m * DM, p.in[1], HB + (size_t)m * DM, lane);
}

__device__ __forceinline__ void row_phase(const float* Y, const float* xin, float* xout, const float* gpost, const float* gpre, bf16_t* HB,
                                          const float* wf, const float* fbias, float* LOGF, int gw, int NGW, int lane) {
    for (int m = gw; m < MTOK; m += NGW) {
        const f32x4* yr = (const f32x4*)(Y + (size_t)m * DM); const f32x4* xr = (const f32x4*)(xin + (size_t)m * DM); f32x4* orow = (f32x4*)(xout + (size_t)m * DM);
        f32x4 v[8]; float s = 0.f;
#pragma unroll
        for (int j = 0; j < 8; ++j) { v[j] = yr[lane + 64 * j]; s += (v[j].x * v[j].x + v[j].y * v[j].y) + (v[j].z * v[j].z + v[j].w * v[j].w); }
        const float rstd_y = 1.0f / sqrtf(wave_sum(s) * (1.0f / DM) + RMS_EPS);
        float s2 = 0.f;
#pragma unroll
        for (int j = 0; j < 8; ++j) { const f32x4 gg = ((const f32x4*)gpost)[lane + 64 * j]; const f32x4 xx = xr[lane + 64 * j];
            v[j] = xx + v[j] * rstd_y * gg; orow[lane + 64 * j] = v[j];
            s2 += (v[j].x * v[j].x + v[j].y * v[j].y) + (v[j].z * v[j].z + v[j].w * v[j].w); }
        if (gpre) {
            const float rstd = 1.0f / sqrtf(wave_sum(s2) * (1.0f / DM) + RMS_EPS);
#pragma unroll
            for (int j = 0; j < 8; ++j) { const f32x4 gg = ((const f32x4*)gpre)[lane + 64 * j]; v[j] = v[j] * rstd * gg;
                u32x2 w; w.x = pk2(v[j].x, v[j].y); w.y = pk2(v[j].z, v[j].w); ((u32x2*)(HB + (size_t)m * DM))[lane + 64 * j] = w; }
            if (wf) {
                f32x4 a0 = {0.f, 0.f, 0.f, 0.f}, a1 = a0, a2 = a0, a3 = a0;
#pragma unroll
                for (int j = 0; j < 8; ++j)
#pragma unroll
                    for (int e = 0; e < 4; ++e) { const f32x4* wp = (const f32x4*)(wf + (size_t)(4 * lane + 256 * j + e) * NCF); const float hv = v[j][e];
                        a0 += wp[0] * hv; a1 += wp[1] * hv; a2 += wp[2] * hv; a3 += wp[3] * hv; }
                float mine = 0.f;
#pragma unroll
                for (int q = 0; q < 4; ++q) { const float t0 = wave_sum(a0[q]), t1 = wave_sum(a1[q]), t2 = wave_sum(a2[q]), t3 = wave_sum(a3[q]);
                    mine = lane == q ? t0 : mine; mine = lane == 4 + q ? t1 : mine; mine = lane == 8 + q ? t2 : mine; mine = lane == 12 + q ? t3 : mine; }
                if (lane < 16) { const float z = mine + fbias[lane]; const float lf = fminf(z, 0.f) - log1pf(expf(-fabsf(z))); LOGF[(size_t)m * 16 + lane] = lf; }
            }
        }
    }
}

__device__ __forceinline__ void cumsum_phase(const float* LOGF, float* CUMB, LAS float* sc, int G, int blk, int tid) {
    const int lane = tid & 63, wave = tid >> 6;
    for (int bh = blk; bh < NBATCH * NHEAD; bh += G) {
        const int b = bh >> 4, hh = bh & 15; const int t0 = 4 * tid;
        float v[4];
#pragma unroll
        for (int e = 0; e < 4; ++e) v[e] = LOGF[((size_t)(b * SEQ + t0 + e)) * 16 + hh];
        v[1] += v[0]; v[2] += v[1]; v[3] += v[2];
        float incl = v[3];
#pragma unroll
        for (int o = 1; o < 64; o <<= 1) { const float t = __shfl_up(incl, o); if (lane >= o) incl += t; }
        if (lane == 63) sc[wave] = incl;
        __syncthreads();
        float woff = 0.f;
        for (int i = 0; i < wave; ++i) woff += sc[i];
        const float excl = incl - v[3] + woff;
        f32x4 o; o.x = -(excl + v[0]) * LOG2E; o.y = -(excl + v[1]) * LOG2E; o.z = -(excl + v[2]) * LOG2E; o.w = -(excl + v[3]) * LOG2E;
        *(f32x4*)(CUMB + (size_t)bh * SEQ + t0) = o;
        __syncthreads();
    }
}

__device__ __forceinline__ unsigned off_b(unsigned row, unsigned ch) { return 256u * row + 16u * (ch ^ (((row & 3u) << 2) | ((row >> 2) & 3u))); }
#define MFMA32(a, b, c) __builtin_amdgcn_mfma_f32_32x32x16_bf16((a), (b), (c), 0, 0, 0)
template <int MODE>
__device__ __forceinline__ void attn_phase(LAS unsigned char* L, const bf16_t* PROJ, bf16_t* ACT, const float* bias_src, int G, int blk, const int tid) {
    const int  lane = tid & 63, w = __builtin_amdgcn_readfirstlane(tid >> 6), c = lane & 31, hi = lane >> 5;
    LAS float* T = (LAS float*)(L + 65536);
    const int srow = tid >> 4, sch = tid & 15;
    const unsigned soff0 = off_b(srow, sch), soff1 = off_b(srow + 32, sch);
    const unsigned kaddr = 256u * c + 16u * ((unsigned)hi ^ (((c & 3u) << 2) | ((c >> 2) & 3u)));
    const unsigned blk16 = (lane >> 4) & 1, q4 = (lane & 15) >> 2, p4 = lane & 3;
    const unsigned vbase0 = 256u * (4u * hi + q4) + 8u * (p4 & 1u);
    const unsigned vb = 64u * q4 + 16u * (((2u * blk16 + (p4 >> 1)) ^ (unsigned)hi));
    const int nit = G == 256 ? 8 : (NBATCH * NHEAD * 8 + G - 1) / G;
    for (int it = 0; it < nit; ++it) {
        int bh, qb;
        if (G == 256) { const int x = blk & 7, j = blk >> 3; bh = x * 32 + it * 4 + (j >> 3); qb = (j + it) & 7; }
        else { const int unit = it * G + blk; if (unit >= NBATCH * NHEAD * 8) break; bh = unit & 255; qb = unit >> 8; }
        const int b = bh >> 4, h = bh & 15;
        __syncthreads();
        if (MODE == 0) { for (int i = tid; i < 639; i += 512) { int d = 575 - i; d = d < -256 ? -256 : (d > 256 ? 256 : d); T[i] = bias_src[h * NREL + d + 256] * LOG2E; } }
        else { for (int i = tid; i < (qb + 1) * 256; i += 512) T[i] = bias_src[(size_t)bh * SEQ + i]; }
        const int qrow = qb * 256 + w * 32 + c;
        const bf16_t* qp = PROJ + (size_t)(b * SEQ + qrow) * NA + h * HD + 8 * hi;
        bf16x8 qf[8];
#pragma unroll
        for (int s = 0; s < 8; ++s) qf[s] = *(const bf16x8*)(qp + 16 * s);
        const int kt_hi = 4 * qb + 3, kt_lo = MODE == 0 ? (4 * qb - 8 > 0 ? 4 * qb - 8 : 0) : 0;
        const int cw = 4 * qb + (w >> 1);
        const bf16_t* kg = PROJ + (size_t)(b * SEQ + srow) * NA + DM + h * HD + sch * 8;
        u32x4 st0, st1, st2, st3;
        { const bf16_t* g0 = kg + (size_t)kt_lo * 64 * NA;
          st0 = *(const u32x4*)g0; st1 = *(const u32x4*)(g0 + (size_t)32 * NA); st2 = *(const u32x4*)(g0 + DM); st3 = *(const u32x4*)(g0 + (size_t)32 * NA + DM); }
        *(LAS u32x4*)(L + soff0) = st0; *(LAS u32x4*)(L + soff1) = st1; *(LAS u32x4*)(L + 32768 + soff0) = st2; *(LAS u32x4*)(L + 32768 + soff1) = st3;
        f32x16 o0, o1, o2, o3;
#pragma unroll
        for (int r = 0; r < 16; ++r) { o0[r] = 0.f; o1[r] = 0.f; o2[r] = 0.f; o3[r] = 0.f; }
        float mrun = -1e30f, lrun = 0.f;
#pragma unroll
        for (int s = 0; s < 8; ++s) asm volatile("" : "+v"(qf[s]));
        __syncthreads();
        int cur = 0;
        for (int kt = kt_lo; kt <= kt_hi; ++kt) {
            const bool more = kt < kt_hi;
#define PREFETCH_NEXT() if (more) { const bf16_t* g0 = kg + (size_t)(kt + 1) * 64 * NA; \
                st0 = *(const u32x4*)g0; st1 = *(const u32x4*)(g0 + (size_t)32 * NA); st2 = *(const u32x4*)(g0 + DM); st3 = *(const u32x4*)(g0 + (size_t)32 * NA + DM); }
            const bool active = MODE == 0 ? (kt >= cw - 8 && kt <= cw) : (kt <= cw);
            if (active) {
                LAS unsigned char* Kb = L + cur * 16384; LAS unsigned char* Vb = L + 32768 + cur * 16384;
                unsigned kaddr_t = kaddr, vb_t = vb; asm volatile("" : "+v"(kaddr_t), "+v"(vb_t));
                unsigned va[4][2];
#pragma unroll
                for (int db = 0; db < 4; ++db)
#pragma unroll
                    for (int t = 0; t < 2; ++t) va[db][t] = vbase0 + (vb_t ^ (unsigned)(64 * db + 32 * t)) + 2048u * t;
                f32x16 s0, s1;
                if (MODE == 0) { const LAS float* tb = T + (575 - (qrow - kt * 64) + 4 * hi);
#pragma unroll
                    for (int r = 0; r < 16; ++r) { const int cr = (r & 3) + 8 * (r >> 2); s0[r] = tb[cr]; s1[r] = tb[32 + cr]; } }
                else { const int base = kt * 64 + 4 * hi;
#pragma unroll
                    for (int r = 0; r < 16; ++r) { const int cr = (r & 3) + 8 * (r >> 2); s0[r] = T[base + cr]; s1[r] = T[base + 32 + cr]; } }
#define KLOAD(D0, D1, S) { const unsigned a_ = kaddr_t ^ (unsigned)((S) << 5); D0 = *(const LAS bf16x8*)(Kb + a_); D1 = *(const LAS bf16x8*)(Kb + a_ + 8192); }
#define QK2(A0, A1, B0, B1, S) { s0 = MFMA32(A0, qf[S], s0); s1 = MFMA32(A1, qf[S], s1); s0 = MFMA32(B0, qf[(S) + 1], s0); s1 = MFMA32(B1, qf[(S) + 1], s1); }
#define VLOAD(DST, DB) { _Pragma("unroll") for (int ks = 0; ks < 4; ++ks) { \
                    const s16x4 lo = __builtin_amdgcn_ds_read_tr16_b64_v4i16((LAS s16x4*)(Vb + va[DB][0] + 4096 * ks)); \
                    const s16x4 hh = __builtin_amdgcn_ds_read_tr16_b64_v4i16((LAS s16x4*)(Vb + va[DB][1] + 4096 * ks)); \
                    DST[ks] = __builtin_shufflevector(lo, hh, 0, 1, 2, 3, 4, 5, 6, 7); } }
#define PV4(OD, SRC) { _Pragma("unroll") for (int ks = 0; ks < 4; ++ks) OD = MFMA32(SRC[ks], pb[ks], OD); }
#define SGB_DS_MFMA(NDS) { __builtin_amdgcn_sched_group_barrier(0x100, NDS, 0); __builtin_amdgcn_sched_group_barrier(0x008, 4, 0); }
                bf16x8 ka0, ka1, ka2, ka3, kb0, kb1, kb2, kb3, vA[4], vB[4];
                KLOAD(ka0, ka1, 0) KLOAD(ka2, ka3, 1)
                __builtin_amdgcn_sched_barrier(0);
                KLOAD(kb0, kb1, 2) KLOAD(kb2, kb3, 3) QK2(ka0, ka1, ka2, ka3, 0) SGB_DS_MFMA(4)
                __builtin_amdgcn_sched_barrier(0);
                KLOAD(ka0, ka1, 4) KLOAD(ka2, ka3, 5) QK2(kb0, kb1, kb2, kb3, 2) SGB_DS_MFMA(4)
                __builtin_amdgcn_sched_barrier(0);
                KLOAD(kb0, kb1, 6) KLOAD(kb2, kb3, 7) QK2(ka0, ka1, ka2, ka3, 4) SGB_DS_MFMA(4)
                __builtin_amdgcn_sched_barrier(0);
                VLOAD(vA, 0) QK2(kb0, kb1, kb2, kb3, 6) SGB_DS_MFMA(8)
                __builtin_amdgcn_sched_barrier(0);
                PREFETCH_NEXT()
                __builtin_amdgcn_sched_barrier(0);
                if (MODE == 1 && kt == cw) {
                    const int rel = qrow - kt * 64 - 4 * hi;
#pragma unroll
                    for (int r = 0; r < 16; ++r) { const int cr = (r & 3) + 8 * (r >> 2);
                        s0[r] = cr <= rel ? s0[r] : -__builtin_inff(); s1[r] = cr + 32 <= rel ? s1[r] : -__builtin_inff(); } }
                float mx = fmaxf(s0[0], s1[0]);
#pragma unroll
                for (int r = 1; r < 16; ++r) mx = fmaxf(mx, fmaxf(s0[r], s1[r]));
                mx = fmaxf(mx, __shfl_xor(mx, 32));
                if (!__all(mx <= mrun + 8.0f)) {
                    const float mn = fmaxf(mrun, mx), alpha = __builtin_amdgcn_exp2f(mrun - mn); mrun = mn;
                    lrun *= alpha; o0 *= alpha; o1 *= alpha; o2 *= alpha; o3 *= alpha; }
                float ps = 0.f;
#pragma unroll
                for (int r = 0; r < 16; ++r) { s0[r] = __builtin_amdgcn_exp2f(s0[r] - mrun); s1[r] = __builtin_amdgcn_exp2f(s1[r] - mrun); ps += s0[r] + s1[r]; }
                lrun += ps;
                bf16x8 pb[4];
#pragma unroll
                for (int ks = 0; ks < 2; ++ks) { u32x4 a, bq;
                    a.x = pk2(s0[8 * ks + 0], s0[8 * ks + 1]); a.y = pk2(s0[8 * ks + 2], s0[8 * ks + 3]); a.z = pk2(s0[8 * ks + 4], s0[8 * ks + 5]); a.w = pk2(s0[8 * ks + 6], s0[8 * ks + 7]);
                    bq.x = pk2(s1[8 * ks + 0], s1[8 * ks + 1]); bq.y = pk2(s1[8 * ks + 2], s1[8 * ks + 3]); bq.z = pk2(s1[8 * ks + 4], s1[8 * ks + 5]); bq.w = pk2(s1[8 * ks + 6], s1[8 * ks + 7]);
                    pb[ks] = __builtin_bit_cast(bf16x8, a); pb[2 + ks] = __builtin_bit_cast(bf16x8, bq); }
                __builtin_amdgcn_sched_barrier(0);
                VLOAD(vB, 1) PV4(o0, vA) SGB_DS_MFMA(8)
                __builtin_amdgcn_sched_barrier(0);
                VLOAD(vA, 2) PV4(o1, vB) SGB_DS_MFMA(8)
                __builtin_amdgcn_sched_barrier(0);
                VLOAD(vB, 3) PV4(o2, vA) SGB_DS_MFMA(8)
                __builtin_amdgcn_sched_barrier(0);
                PV4(o3, vB)
                __builtin_amdgcn_sched_barrier(0);
#undef KLOAD
#undef QK2
#undef VLOAD
#undef PV4
#undef SGB_DS_MFMA
            }
            if (!active) { PREFETCH_NEXT() }
#undef PREFETCH_NEXT
            if (more) { LAS unsigned char* Kn = L + (cur ^ 1) * 16384; LAS unsigned char* Vn = L + 32768 + (cur ^ 1) * 16384;
                *(LAS u32x4*)(Kn + soff0) = st0; *(LAS u32x4*)(Kn + soff1) = st1; *(LAS u32x4*)(Vn + soff0) = st2; *(LAS u32x4*)(Vn + soff1) = st3; }
            __syncthreads();
            cur ^= 1;
        }
        lrun += __shfl_xor(lrun, 32);
        const float inv = 1.0f / lrun;
        const bf16_t* gp = PROJ + (size_t)(b * SEQ + qrow) * NA + 3 * DM + h * HD + 4 * hi;
        bf16_t* op = ACT + (size_t)(b * SEQ + qrow) * DM + h * HD + 4 * hi;
#define O_STORE(OD, DB) _Pragma("unroll") for (int g4 = 0; g4 < 4; ++g4) { const u32x2 sg = *(const u32x2*)(gp + 32 * DB + 8 * g4); \
            u32x2 ov; ov.x = pk2(OD[4 * g4 + 0] * inv * bflo(sg.x), OD[4 * g4 + 1] * inv * bfhi(sg.x)); ov.y = pk2(OD[4 * g4 + 2] * inv * bflo(sg.y), OD[4 * g4 + 3] * inv * bfhi(sg.y)); \
            *(u32x2*)(op + 32 * DB + 8 * g4) = ov; }
        O_STORE(o0, 0) O_STORE(o1, 1) O_STORE(o2, 2) O_STORE(o3, 3)
#undef O_STORE
    }
}

#define MFMA16(a, b, c) __builtin_amdgcn_mfma_f32_16x16x32_bf16((a), (b), (c), 0, 0, 0)
constexpr int XC_LD = 168, LA_LD = 164;
__device__ __forceinline__ void rglru_phase(LAS unsigned char* L, const bf16_t* PROJ, bf16_t* ACT, const float* conv_w, const float* conv_b, const bf16x8* GW, const float* gab,
                                            const float* gxb, const float* lam, int G, int blk, const int tid) {
    const int  lane = tid & 63, w = __builtin_amdgcn_readfirstlane(tid >> 6), fr = lane & 15, fq = lane >> 4;
    LAS bf16_t* XC = (LAS bf16_t*)L;
    LAS float* LA = (LAS float*)(L + 21504);
    LAS float* LU = (LAS float*)(L + 21504 + 41984);
    LAS float* CW = (LAS float*)(L + 21504 + 2 * 41984);
    for (int unit = blk; unit < NBATCH * 16; unit += G) {
        const int b = unit >> 4, nb = unit & 15, ch0 = nb * 160;
        __syncthreads();
        for (int i = tid; i < 800; i += 512) { const int j = i / 160, ch = i - j * 160; CW[i] = j < 4 ? conv_w[j * RGW + ch0 + ch] : conv_b[ch0 + ch]; }
        bf16x8 wa0[5], wx0[5], wa1[5], wx1[5];
        const int col0 = w * 16 + fr, col1 = (8 + (w >> 2)) * 16 + fr;
        { const bf16x8* ga0 = GW + ((size_t)((0 * 16 + nb) * 10 + w) * 5) * 64 + lane; const bf16x8* gx0 = GW + ((size_t)((1 * 16 + nb) * 10 + w) * 5) * 64 + lane;
          const bf16x8* ga1 = GW + ((size_t)((0 * 16 + nb) * 10 + 8 + (w >> 2)) * 5) * 64 + lane; const bf16x8* gx1 = GW + ((size_t)((1 * 16 + nb) * 10 + 8 + (w >> 2)) * 5) * 64 + lane;
#pragma unroll
          for (int ks = 0; ks < 5; ++ks) { wa0[ks] = ga0[ks * 64]; wx0[ks] = gx0[ks * 64]; wa1[ks] = ga1[ks * 64]; wx1[ks] = gx1[ks * 64]; } }
        const float ba0 = gab[ch0 + col0], bx0 = gxb[ch0 + col0], ba1 = gab[ch0 + col1], bx1 = gxb[ch0 + col1];
        const float l0 = lam[ch0 + col0], l1 = lam[ch0 + col1];
        const float sp0 = -8.0f * LOG2E * (fmaxf(-l0, 0.f) + log1pf(expf(-fabsf(l0)))), sp1 = -8.0f * LOG2E * (fmaxf(-l1, 0.f) + log1pf(expf(-fabsf(l1))));
        float hstate = 0.f;
        __syncthreads();
        for (int chunk = 0; chunk < SEQ / 64; ++chunk) {
            const int t0 = chunk * 64;
#pragma unroll
            for (int it = 0; it < 5; ++it) { const int i = tid + 512 * it, t = i / 40, c4 = (i - t * 40) * 4;
                f32x4 acc = *(const LAS f32x4*)(CW + 640 + c4);
#pragma unroll
                for (int j = 0; j < 4; ++j) { const int tt = t0 + t - 3 + j;
                    if (tt >= 0) { const u32x2 xv = *(const u32x2*)(PROJ + (size_t)(b * SEQ + tt) * NBP + ch0 + c4); const f32x4 cw4 = *(const LAS f32x4*)(CW + j * 160 + c4);
                        acc.x += bflo(xv.x) * cw4.x; acc.y += bfhi(xv.x) * cw4.y; acc.z += bflo(xv.y) * cw4.z; acc.w += bfhi(xv.y) * cw4.w; } }
                u32x2 o; o.x = pk2(acc.x, acc.y); o.y = pk2(acc.z, acc.w); *(LAS u32x2*)(XC + t * XC_LD + c4) = o; }
            __syncthreads();
#define GATE_TILE(RT, COL, WA, WX, BA, BX, SP) { f32x4 aa = {0.f, 0.f, 0.f, 0.f}, ax = {0.f, 0.f, 0.f, 0.f}; \
                _Pragma("unroll") for (int ks = 0; ks < 5; ++ks) { const bf16x8 af = *(const LAS bf16x8*)(XC + ((RT) * 16 + fr) * XC_LD + 32 * ks + 8 * fq); aa = MFMA16(af, WA[ks], aa); ax = MFMA16(af, WX[ks], ax); } \
                _Pragma("unroll") for (int rg = 0; rg < 4; ++rg) { const int t = (RT) * 16 + fq * 4 + rg; \
                    const float r = fast_sigmoid(aa[rg] + BA), ig = fast_sigmoid(ax[rg] + BX); const float a = __builtin_amdgcn_exp2f(SP * r); \
                    const float xv = __uint_as_float((unsigned)XC[t * XC_LD + (COL)] << 16); const float u = sqrtf(fmaxf(1.0f - a * a, 0.f)) * ig * xv; \
                    LA[t * LA_LD + (COL)] = a; LU[t * LA_LD + (COL)] = u; } }
#pragma unroll
            for (int rt = 0; rt < 4; ++rt) GATE_TILE(rt, col0, wa0, wx0, ba0, bx0, sp0)
            GATE_TILE((w & 3), col1, wa1, wx1, ba1, bx1, sp1)
#undef GATE_TILE
            __syncthreads();
            if (tid < 160) {
#pragma unroll 8
                for (int t = 0; t < 64; ++t) { hstate = LA[t * LA_LD + tid] * hstate + LU[t * LA_LD + tid]; LU[t * LA_LD + tid] = hstate; }
            }
            __syncthreads();
#pragma unroll
            for (int it = 0; it < 5; ++it) { const int i = tid + 512 * it, t = i / 40, c4 = (i - t * 40) * 4;
                const f32x4 hv = *(const LAS f32x4*)(LU + t * LA_LD + c4);
                const u32x2 sg = *(const u32x2*)(PROJ + (size_t)(b * SEQ + t0 + t) * NBP + RGW + ch0 + c4);
                u32x2 o; o.x = pk2(hv.x * bflo(sg.x), hv.y * bfhi(sg.x)); o.y = pk2(hv.z * bflo(sg.y), hv.w * bfhi(sg.y));
                *(u32x2*)(ACT + (size_t)(b * SEQ + t0 + t) * RGW + ch0 + c4) = o; }
        }
    }
}

#define XB_TMO      128
#define XB_XCNT(j)  (256  + 64 * (j))
#define XB_XSUB(j)  (1280 + 64 * (j))
#define XB_XGEN(j)  (2304 + 64 * (j))
#define XB_TOP      3328
#define XB_TOPGEN   3392
#define XCD_BAR_WORDS 3456
#define XB_SPIN_CAP (1u << 18)

__device__ __forceinline__ unsigned xb_ld(unsigned* p)              { return __hip_atomic_load(p, __ATOMIC_RELAXED, __HIP_MEMORY_SCOPE_AGENT); }
__device__ __forceinline__ unsigned xb_add(unsigned* p, unsigned v) { return __hip_atomic_fetch_add(p, v, __ATOMIC_RELAXED, __HIP_MEMORY_SCOPE_AGENT); }
__device__ __forceinline__ unsigned xb_xcc_id() { return (unsigned)__builtin_amdgcn_s_getreg((3 << 11) | 20) & 0xFu; }
#define XB_SPIN(cond, bar) do { unsigned _sp = 0; while (cond) { __builtin_amdgcn_s_sleep(1); \
    if ((++_sp & 255u) == 0u) { if (xb_ld(&(bar)[XB_TMO])) break; if (_sp > XB_SPIN_CAP) { atomicAdd(&(bar)[XB_TMO], 1u); break; } } } } while (0)

struct XcdBarrier {
    unsigned* bar; unsigned x;
    volatile LAS unsigned* st;
};

__device__ __forceinline__ XcdBarrier xcd_barrier_post(unsigned* bar, volatile LAS unsigned* st) {
    XcdBarrier b; b.bar = bar; b.x = xb_xcc_id(); b.st = st;
    if (threadIdx.x == 0) (void)xb_add(&bar[XB_XCNT(b.x)], 1u);
    return b;
}
__device__ __forceinline__ void xcd_barrier_complete(unsigned* bar, unsigned x, unsigned& nloc, unsigned& nx) {
    const unsigned G = gridDim.x * gridDim.y * gridDim.z;
    unsigned sum, cnt, mine, sp = 0u;
    for (;;) {
        sum = 0u; cnt = 0u; mine = 0u;
#pragma unroll
        for (unsigned j = 0; j < 16; ++j) { const unsigned c = xb_ld(&bar[XB_XCNT(j)]); sum += c; cnt += (c > 0u) ? 1u : 0u; mine = (j == x) ? c : mine; }
        if (sum == G) break;
        __builtin_amdgcn_s_sleep(1);
        if ((++sp & 255u) == 0u) { if (xb_ld(&bar[XB_TMO])) break; if (sp > XB_SPIN_CAP) { atomicAdd(&bar[XB_TMO], 1u); break; } }
    }
    nloc = mine > 0u ? mine : 1u; nx = cnt > 0u ? cnt : 1u;
}

__device__ __forceinline__ void xcd_barrier(const XcdBarrier& b) {
    asm volatile("s_waitcnt vmcnt(0)" ::: "memory");
    __syncthreads();
    if (threadIdx.x == 0) {
        unsigned* bar = b.bar;
        __builtin_amdgcn_s_waitcnt(0);
        unsigned nloc = b.st[0], nx = b.st[1];
        if (nloc == 0u) { xcd_barrier_complete(bar, b.x, nloc, nx); b.st[0] = nloc; b.st[1] = nx; }
        const unsigned old = xb_add(&bar[XB_XSUB(b.x)], 1u);
        const unsigned gen = old / nloc;
        if (old + 1u == (gen + 1u) * nloc) {
            __builtin_amdgcn_fence(__ATOMIC_RELEASE, "agent");
            asm volatile("s_waitcnt vmcnt(0)" ::: "memory");
            const unsigned og = xb_add(&bar[XB_TOP], 1u);
            const unsigned tg = og / nx;
            if (og + 1u == (tg + 1u) * nx) xb_add(&bar[XB_TOPGEN], 1u);
            else XB_SPIN(xb_ld(&bar[XB_TOPGEN]) == tg, bar);
            __builtin_amdgcn_fence(__ATOMIC_ACQUIRE, "agent");
            xb_add(&bar[XB_XGEN(b.x)], 1u);
            asm volatile("s_waitcnt vmcnt(0)" ::: "memory");
        } else {
            XB_SPIN(xb_ld(&bar[XB_XGEN(b.x)]) == gen, bar);
            __builtin_amdgcn_fence(__ATOMIC_ACQUIRE, "agent");
            asm volatile("s_waitcnt vmcnt(0)" ::: "memory");
        }
    }
    __syncthreads();
}

#ifndef MK_LAUNCHES
#define MK_LAUNCHES 1
#endif
#ifndef PROBE_REPEAT_MASK
#define PROBE_REPEAT_MASK 0x0
#endif
__global__ void __launch_bounds__(512, 2) hybrid_trunk_mega(Params p) {
    extern __shared__ __attribute__((aligned(16))) unsigned char lds_raw[];
    LAS unsigned char* L = (LAS unsigned char*)lds_raw;
    cg::grid_group grid = cg::this_grid();
    if (threadIdx.x < 4) ((LAS unsigned*)(L + LDS_BYTES - 16))[threadIdx.x] = 0u;
    __syncthreads();
    XcdBarrier xbar = xcd_barrier_post((unsigned*)(p.ws + WS_BAR), (volatile LAS unsigned*)(L + LDS_BYTES - 16));
    const int G = gridDim.x, blk = blockIdx.x;
    unsigned char* ws = p.ws;
    bf16_t* ACT = (bf16_t*)(ws + WS_ACT); bf16_t* PROJ = (bf16_t*)(ws + WS_PROJ); float* Y = (float*)(ws + WS_PROJ);
    float* LOGF = (float*)(ws + WS_LOGF); float* CUMB = (float*)(ws + WS_CUMB);
    for (int ph = p.ph_lo; ph < p.ph_hi; ++ph) {
      for (int rep = 0; rep < (((PROBE_REPEAT_MASK) >> ph) & 1) + 1; ++rep) {
        int tid = threadIdx.x; asm volatile("" : "+v"(tid));
        const int lane = tid & 63, wave = __builtin_amdgcn_readfirstlane(tid >> 6);
        if (ph == 0) {
#ifndef SKIP_PRO
            prologue_phase(p, L, G, blk, wave, lane);
#endif
        }
        else {
            const int layer = (ph - 1) >> 2, sub = (ph - 1) & 3, mix = layer % 3, j = layer / 3;
            if (sub == 0) {
                const bf16_t* Wt = mix == 0 ? (const bf16_t*)(ws + WS_WA_IN + (size_t)j * 32 * MiB) : mix == 1 ? (const bf16_t*)(ws + WS_WB_IN) : (const bf16_t*)(ws + WS_WC_IN);
                const int N = mix == 1 ? NBP : NA;
                if (mix == 2) cumsum_phase(LOGF, CUMB, (LAS float*)L, G, blk, tid);
                pg8::Gemm g{ACT, Wt, MTOK, N, DM}; pg8::StaticOrder S; S.init(MTOK, N, G, blk);
                pg8::EpiProj E{PROJ, N, mix == 1 ? 0 : DM, QSCALE, mix == 1 ? RGW : 3 * DM};
#ifndef SKIP_GEMM1
                pg8::gemm_phase<pg8::EpiProj, pg8::StaticOrder>(L, g, S, E, tid);
#endif
            } else if (sub == 1) {
#ifndef SKIP_ATTN0
                if (mix == 0) attn_phase<0>(L, PROJ, ACT, p.in[4] + (size_t)j * NHEAD * NREL, G, blk, tid);
#endif
#ifndef SKIP_RGLRU
                if (mix == 1) rglru_phase(L, PROJ, ACT, p.in[7], p.in[8], (const bf16x8*)(ws + WS_GW), p.in[10], p.in[12], p.in[13], G, blk, tid);
#endif
#ifndef SKIP_ATTN1
                if (mix == 2) attn_phase<1>(L, PROJ, ACT, CUMB, G, blk, tid);
#endif
            } else if (sub == 2) {
                const bf16_t* Wt = mix == 0 ? (const bf16_t*)(ws + WS_WA_OUT + (size_t)j * 8 * MiB) : mix == 1 ? (const bf16_t*)(ws + WS_WB_OUT) : (const bf16_t*)(ws + WS_WC_OUT);
                const int K = mix == 1 ? RGW : DM;
                pg8::Gemm g{ACT, Wt, MTOK, DM, K}; pg8::StaticOrder S; S.init(MTOK, DM, G, blk);
                pg8::EpiF32 E{Y, DM, nullptr};
#ifndef SKIP_GEMM2
                pg8::gemm_phase<pg8::EpiF32, pg8::StaticOrder>(L, g, S, E, tid);
#endif
            } else {
                const float* xin = layer == 0 ? p.in[0] : p.out;
                const float* gpre = layer < 3 ? p.in[1] + (size_t)(layer + 1) * DM : nullptr;
                const float* wf = (layer + 1) % 3 == 2 && layer < 3 ? p.in[15] + 4 * DM : nullptr;
#ifndef SKIP_ROW
                row_phase(Y, xin, p.out, p.in[2] + (size_t)layer * DM, gpre, ACT, wf, p.in[16], LOGF, blk * 8 + wave, G * 8, lane);
#endif
            }
        }
      }
        if (ph + 1 < p.ph_hi) { if (ph == p.ph_lo) grid.sync(); else xcd_barrier(xbar); }
    }
}

extern "C" void kernel_launch(void* const* d_in, const int* in_sizes, int n_in, void* d_out, int out_size, void* d_ws, size_t ws_size, hipStream_t stream) {
    static int grid = 0;
    if (grid == 0) {
        if (n_in != 18 || in_sizes[0] != MTOK * DM || out_size != MTOK * DM || ws_size < WS_END) {
            fprintf(stderr, "kernel_launch: unexpected shapes (n_in %d, in0 %d, out %d, ws %zu; need ws >= %zu)\n", n_in, n_in > 0 ? in_sizes[0] : -1, out_size, ws_size, (size_t)WS_END); grid = -1; return; }
        int dev = 0, cus = 0, per_cu = 0;
        (void)hipGetDevice(&dev); (void)hipDeviceGetAttribute(&cus, hipDeviceAttributeMultiprocessorCount, dev);
        if (hipFuncSetAttribute((const void*)hybrid_trunk_mega, hipFuncAttributeMaxDynamicSharedMemorySize, LDS_BYTES) != hipSuccess) { fprintf(stderr, "kernel_launch: hipFuncSetAttribute failed\n"); grid = -1; return; }
        if (hipOccupancyMaxActiveBlocksPerMultiprocessor(&per_cu, (const void*)hybrid_trunk_mega, 512, LDS_BYTES) != hipSuccess || per_cu < 1) { fprintf(stderr, "kernel_launch: occupancy query gave %d\n", per_cu); per_cu = 1; }
        (void)hipGetLastError();
        grid = cus * per_cu;
    }
    if (grid < 0) return;
    if (hipMemsetAsync((char*)d_ws + WS_BAR, 0, 16384, stream) != hipSuccess) { fprintf(stderr, "kernel_launch: memset of the barrier words failed\n"); return; }
    Params p{};
    for (int i = 0; i < 18; ++i) p.in[i] = (const float*)d_in[i];
    p.out = (float*)d_out; p.ws = (unsigned char*)d_ws;
#if MK_LAUNCHES == 1
    p.ph_lo = 0; p.ph_hi = NPHASE;
    void* args[] = {&p};
    const hipError_t e = hipLaunchCooperativeKernel((const void*)hybrid_trunk_mega, dim3(grid), dim3(512), args, LDS_BYTES, stream);
    if (e != hipSuccess) fprintf(stderr, "kernel_launch: cooperative launch failed: %s (grid %d)\n", hipGetErrorString(e), grid);
#else
    for (int ph = 0; ph < NPHASE; ++ph) { p.ph_lo = ph; p.ph_hi = ph + 1; hipLaunchKernelGGL(hybrid_trunk_mega, dim3(grid), dim3(512), LDS_BYTES, stream, p); }
#endif
}
```

```cpp
#include <hip/hip_runtime.h>
#include <hip/hip_cooperative_groups.h>
#include <cstdio>
#include <cstdint>
namespace cg = cooperative_groups;
namespace pg8 {
#define PG8_LAS __attribute__((address_space(3)))
typedef unsigned short bf16_t;
typedef short bf16x8 __attribute__((ext_vector_type(8)));
typedef float f32x4 __attribute__((ext_vector_type(4)));
typedef unsigned u32x4 __attribute__((ext_vector_type(4)));
constexpr int BM = 256, BK = 64, HALF = 128, HTB = HALF * BK * 2  , STAGE_BYTES = 8 * HTB, NXCD = 8, WGM = 8;

__host__ __device__ __forceinline__ int lds_byte(int r, int c) { const int st = (r >> 4) * 2 + (c >> 5), rr = r & 15, cc = c & 31, ob = rr * 64 + cc * 2; return st * 1024 + (ob ^ (((ob >> 9) & 1) << 5)); }
__host__ __device__ __forceinline__ void stage_rc(int b, int& R, int& C) { const int st = b / 1024, sb = b % 1024, swz = sb ^ (((sb >> 9) & 1) << 5); R = (st >> 1) * 16 + swz / 64; C = (st & 1) * 32 + (swz % 64) / 2; }
__host__ __device__ __forceinline__ int perm32(int rho) { const int n = rho >> 4, i = rho & 15; return 8 * (i >> 2) + 4 * n + (i & 3); }

struct Unit { int pm, pn; };
struct Gemm { const bf16_t* A; const bf16_t* Bt; int M, N, K; };

struct StaticOrder {
    int nM, nN, nwg, G, c;
    __host__ __device__ void init(int M, int N, int G_, int c_) { nM = M / BM; nN = N / BM; nwg = nM * nN; G = G_; c = c_; }
    __host__ __device__ bool next(int i, Unit& u) const {
        const long L = (long)i * G + c; if (L >= nwg) return false;
        int wgid = (int)L; { const int q = nwg / NXCD, r = nwg % NXCD, xcd = wgid % NXCD, off = wgid / NXCD; wgid = (xcd < r ? xcd * (q + 1) : r * (q + 1) + (xcd - r) * q) + off; }
        const int nig = WGM * nN, gid = wgid / nig, fm = gid * WGM, gsz = (nM - fm) < WGM ? (nM - fm) : WGM;
        u.pm = fm + ((wgid % nig) % gsz); u.pn = (wgid % nig) / gsz; return true;
    }
    __device__ __forceinline__ void a_ready(const Unit&) const {}
    __device__ __forceinline__ void done(const Unit&) const {}
};
__device__ __forceinline__ unsigned cvt_pk_bf16(float lo, float hi) { unsigned r; asm volatile("v_cvt_pk_bf16_f32 %0, %1, %2" : "=v"(r) : "v"(lo), "v"(hi)); return r; }
typedef float f32x2 __attribute__((ext_vector_type(2)));
struct EpiF32 {
    static constexpr bool PERM = false, AFTER_DRAIN = false;
    float* C; int ldc; const float* bias;
    __device__ __forceinline__ void operator()(const f32x4 (&acc)[2][2][4][2], const Unit& u, int wr, int wc, int fr, int fq) const {
        const int row0 = u.pm * BM + wr * 64 + fr, col0 = u.pn * BM + wc * 32 + 4 * fq;
        f32x4 bv[2][2];
#pragma unroll
        for (int bj = 0; bj < 2; ++bj)
#pragma unroll
            for (int n = 0; n < 2; ++n) bv[bj][n] = bias ? *(const f32x4*)(bias + col0 + bj * HALF + n * 16) : (f32x4){0.f, 0.f, 0.f, 0.f};
#pragma unroll
        for (int ai = 0; ai < 2; ++ai)
#pragma unroll
            for (int m = 0; m < 4; ++m) { float* rowp = C + (size_t)(row0 + ai * HALF + m * 16) * ldc + col0;
#pragma unroll
                for (int bj = 0; bj < 2; ++bj)
#pragma unroll
                    for (int n = 0; n < 2; ++n) *(f32x4*)(rowp + bj * HALF + n * 16) = acc[ai][bj][m][n] + bv[bj][n]; }
    }
};
template <class Epi, class Sched>
__device__ __forceinline__ void gemm_phase(PG8_LAS unsigned char* lds, const Gemm g, const Sched& S, const Epi& E, const int tid_in) {
    const int tid = tid_in, wid = __builtin_amdgcn_readfirstlane(tid >> 6), lane = tid & 63, wr = wid >> 2, wc = wid & 3, fr = lane & 15, fq = lane >> 4;
    const int K = g.K, nt = K / BK;
    unsigned voffA[2], voffB[2];
#pragma unroll
    for (int i = 0; i < 2; ++i) { int R, C; stage_rc(tid * 16 + i * 8192, R, C); const int Rb = Epi::PERM ? ((R & ~31) + perm32(R & 31)) : R;
        voffA[i] = (unsigned)(R * K + C) * 2u; voffB[i] = (unsigned)(Rb * K + C) * 2u; }
    const size_t kstep = (size_t)(BK * 2);
    const size_t hstep = (size_t)HALF * K * 2;
    const size_t tstep = 2 * hstep;
    const unsigned ldsw = (unsigned)wid * 1024u;
    const int aoff = lds_byte(wr * 64 + fr, fq * 8), boff = lds_byte(wc * 32 + fr, fq * 8);
#define PG8_SA(b, h) (((b) * 2 + (h)) * HTB)
#define PG8_SB(b, h) ((4 + (b) * 2 + (h)) * HTB)
#define PG8_STAGE(bufoff, gbase, voff) do { _Pragma("unroll") for (int _i = 0; _i < 2; ++_i) \
        __builtin_amdgcn_global_load_lds((const unsigned*)((const char*)(gbase) + (voff)[_i]), (PG8_LAS unsigned*)(lds + (bufoff) + ldsw + _i * 8192), 16, 0, 0); } while (0)
#define PG8_LDA(dst, b, h) do { _Pragma("unroll") for (int m = 0; m < 4; ++m) _Pragma("unroll") for (int k = 0; k < 2; ++k) dst[m][k] = *(const PG8_LAS bf16x8*)(lds + PG8_SA(b, h) + aoff + m * 2048 + k * 1024); } while (0)
#define PG8_LDB(dst, b, h) do { _Pragma("unroll") for (int n = 0; n < 2; ++n) _Pragma("unroll") for (int k = 0; k < 2; ++k) dst[n][k] = *(const PG8_LAS bf16x8*)(lds + PG8_SB(b, h) + boff + n * 2048 + k * 1024); } while (0)
#define PG8_MMA(ai, bj, At, Bt) do { __builtin_amdgcn_s_setprio(1); _Pragma("unroll") for (int m = 0; m < 4; ++m) _Pragma("unroll") for (int n = 0; n < 2; ++n) _Pragma("unroll") for (int k = 0; k < 2; ++k) \
        acc[ai][bj][m][n] = __builtin_amdgcn_mfma_f32_16x16x32_bf16(Bt[n][k], At[m][k], acc[ai][bj][m][n], 0, 0, 0); __builtin_amdgcn_s_setprio(0); } while (0)
#define PG8_WAIT_V(n) asm volatile("s_waitcnt vmcnt(" #n ")" ::: "memory")
#define PG8_WAIT_L(n) asm volatile("s_waitcnt lgkmcnt(" #n ")" ::: "memory")
#define PG8_BAR __builtin_amdgcn_s_barrier()
#define PG8_SCHED __builtin_amdgcn_sched_barrier(0)
    Unit cur, nxt; int ui = 0;
    if (!S.next(0, cur)) return;
    f32x4 acc[2][2][4][2];
#pragma unroll
    for (int a = 0; a < 2; ++a)
#pragma unroll
        for (int b = 0; b < 2; ++b)
#pragma unroll
            for (int m = 0; m < 4; ++m)
#pragma unroll
                for (int n = 0; n < 2; ++n) acc[a][b][m][n] = (f32x4){0.f, 0.f, 0.f, 0.f};
    bf16x8 At[4][2], B0[2][2], B1[2][2];
    const char* cA = (const char*)g.A + (size_t)cur.pm * tstep; const char* cB = (const char*)g.Bt + (size_t)cur.pn * tstep;
    S.a_ready(cur);
    PG8_STAGE(PG8_SB(0, 0), cB, voffB); PG8_STAGE(PG8_SA(0, 0), cA, voffA); PG8_STAGE(PG8_SB(0, 1), cB + hstep, voffB); PG8_STAGE(PG8_SA(0, 1), cA + hstep, voffA);
    if (wr == 1) PG8_BAR;
    PG8_WAIT_V(4); PG8_BAR;
    PG8_STAGE(PG8_SB(1, 0), cB + kstep, voffB); PG8_STAGE(PG8_SA(1, 0), cA + kstep, voffA); PG8_STAGE(PG8_SB(1, 1), cB + hstep + kstep, voffB);
    PG8_WAIT_V(6); PG8_BAR;
    for (;;) {
        const bool has_next = S.next(ui + 1, nxt);
        const char* nA = has_next ? (const char*)g.A + (size_t)nxt.pm * tstep : cA; const char* nB = has_next ? (const char*)g.Bt + (size_t)nxt.pn * tstep : cB;
        for (int t = 0; t < nt; t += 2) {
            const bool last = (t == nt - 2);
            const char* a1 = cA + (size_t)(t + 1) * kstep;
            const char* a2 = last ? nA : cA + (size_t)(t + 2) * kstep; const char* b2 = last ? nB : cB + (size_t)(t + 2) * kstep;
            const char* a3 = a2 + kstep; const char* b3 = b2 + kstep;
            if (last && has_next) S.a_ready(nxt);
            PG8_LDB(B0, 0, 0); PG8_SCHED; PG8_LDA(At, 0, 0); PG8_STAGE(PG8_SA(1, 1), a1 + hstep, voffA);
            PG8_WAIT_L(8); PG8_BAR; PG8_WAIT_L(0); PG8_MMA(0, 0, At, B0); PG8_BAR; PG8_SCHED;
            PG8_LDB(B1, 0, 1); PG8_STAGE(PG8_SB(0, 0), b2, voffB);
            PG8_BAR; PG8_WAIT_L(0); PG8_MMA(0, 1, At, B1); PG8_BAR;
            PG8_LDA(At, 0, 1); PG8_STAGE(PG8_SA(0, 0), a2, voffA);
            PG8_BAR; PG8_WAIT_L(0); PG8_MMA(1, 0, At, B0); PG8_BAR; PG8_SCHED;
            PG8_STAGE(PG8_SB(0, 1), b2 + hstep, voffB);
            PG8_WAIT_V(6); PG8_BAR; PG8_MMA(1, 1, At, B1); PG8_BAR;
            PG8_LDB(B0, 1, 0); PG8_SCHED; PG8_LDA(At, 1, 0); PG8_STAGE(PG8_SA(0, 1), a2 + hstep, voffA);
            PG8_WAIT_L(8); PG8_BAR; PG8_WAIT_L(0); PG8_MMA(0, 0, At, B0); PG8_BAR; PG8_SCHED;
            PG8_LDB(B1, 1, 1); PG8_STAGE(PG8_SB(1, 0), b3, voffB);
            PG8_BAR; PG8_WAIT_L(0); PG8_MMA(0, 1, At, B1); PG8_BAR;
            PG8_LDA(At, 1, 1); PG8_STAGE(PG8_SA(1, 0), a3, voffA);
            PG8_BAR; PG8_WAIT_L(0); PG8_MMA(1, 0, At, B0); PG8_BAR; PG8_SCHED;
            PG8_STAGE(PG8_SB(1, 1), b3 + hstep, voffB);
            PG8_WAIT_V(6); PG8_BAR; PG8_MMA(1, 1, At, B1); PG8_BAR;
        }
        if constexpr (!Epi::AFTER_DRAIN) { E(acc, cur, wr, wc, fr, fq); S.done(cur); }
        if (!has_next) break;
#pragma unroll
        for (int a = 0; a < 2; ++a)
#pragma unroll
            for (int b = 0; b < 2; ++b)
#pragma unroll
                for (int m = 0; m < 4; ++m)
#pragma unroll
                    for (int n = 0; n < 2; ++n) acc[a][b][m][n] = (f32x4){0.f, 0.f, 0.f, 0.f};
        cur = nxt; cA = nA; cB = nB; ++ui;
    }
    PG8_WAIT_V(0);
    if (wr == 0) PG8_BAR;
    PG8_BAR;
    if constexpr (Epi::AFTER_DRAIN) { E.fused(acc, cur, wr, wc, fr, fq, lds, wid, lane); S.done(cur); }
#undef PG8_SA
#undef PG8_SB
#undef PG8_STAGE
#undef PG8_LDA
#undef PG8_LDB
#undef PG8_MMA
#undef PG8_WAIT_V
#undef PG8_WAIT_L
#undef PG8_BAR
#undef PG8_SCHED
}
}

#define LAS __attribute__((address_space(3)))
typedef unsigned short bf16_t;
typedef short bf16x8 __attribute__((ext_vector_type(8)));
typedef short s16x4 __attribute__((ext_vector_type(4)));
typedef float f32x4 __attribute__((ext_vector_type(4)));
typedef float f32x2 __attribute__((ext_vector_type(2)));
typedef float f32x16 __attribute__((ext_vector_type(16)));
typedef unsigned u32x4 __attribute__((ext_vector_type(4)));
typedef unsigned u32x2 __attribute__((ext_vector_type(2)));
typedef __bf16 bf16v2 __attribute__((ext_vector_type(2)));

constexpr int DM = 2048, SEQ = 2048, NBATCH = 16, MTOK = NBATCH * SEQ;
constexpr int NHEAD = 16, HD = 128;
constexpr int NA = 8192, NBP = 5120, RGW = 2560, NCF = 8208, NREL = 513;
constexpr float RMS_EPS = 1e-6f, LOG2E = 1.4426950408889634f;
constexpr float QSCALE = 0.08838834764831845f * 1.4426950408889634f;
constexpr size_t MiB = (size_t)1 << 20;
constexpr size_t WS_WA_IN = 0, WS_WA_OUT = 64 * MiB, WS_WB_IN = 80 * MiB, WS_WB_OUT = 100 * MiB, WS_WC_IN = 110 * MiB, WS_WC_OUT = 142 * MiB;
constexpr size_t WS_LOGF = 150 * MiB, WS_CUMB = 152 * MiB, WS_GW = 154 * MiB, WS_CTL = 156 * MiB, WS_BAR = WS_CTL, WS_CNT = WS_CTL + 65536, CTL_BYTES = 262144, WS_YS = 157 * MiB, WS_ACT = 160 * MiB, WS_PROJ = 320 * MiB, WS_XB = 832 * MiB, WS_XS = 960 * MiB, WS_END = 964 * MiB;
constexpr int LDS_BYTES = 147456;
constexpr int NPHASE = 17;

struct Params { const float* in[18]; float* out; unsigned char* ws; int ph_lo, ph_hi; };

__device__ __forceinline__ unsigned pk2(float a, float b) { const bf16v2 v = __builtin_convertvector((f32x2){a, b}, bf16v2); return __builtin_bit_cast(unsigned, v); }
__device__ __forceinline__ float bflo(unsigned w) { return __uint_as_float(w << 16); }
__device__ __forceinline__ float bfhi(unsigned w) { return __uint_as_float(w & 0xffff0000u); }
__device__ __forceinline__ float wave_sum(float v) {
#pragma unroll
    for (int o = 1; o < 64; o <<= 1) v += __shfl_xor(v, o);
    return v;
}
__device__ __forceinline__ float log1pexp_neg_abs(float x) { const float z = __builtin_amdgcn_exp2f(-LOG2E * __builtin_fabsf(x));
    const float ser = z * (1.0f - z * (0.5f - z * (0.33333334f - 0.25f * z))), lg = __builtin_amdgcn_logf(1.0f + z) * 0.6931471805599453f; return z < 0.06f ? ser : lg; }
__device__ __forceinline__ float fast_sigmoid(float z) { return __builtin_amdgcn_rcpf(1.0f + __builtin_amdgcn_exp2f(-LOG2E * z)); }

namespace pg8 {
typedef __bf16 bf16v2_t __attribute__((ext_vector_type(2))); typedef float f32v2_t __attribute__((ext_vector_type(2)));
__device__ __forceinline__ unsigned cvt2(float lo, float hi) { const bf16v2_t v = __builtin_convertvector((f32v2_t){lo, hi}, bf16v2_t); return __builtin_bit_cast(unsigned, v); }
__device__ __forceinline__ float slot_sum8(const float* s) { float t = 0.f;
#pragma unroll
    for (int q = 0; q < 8; ++q) t += s[q];
    return t; }
struct EpiProj {
    static constexpr bool PERM = true, AFTER_DRAIN = false;
    bf16_t* O; int ldc; int q_end; float qscale; int g_begin; const float* rstd;
    const LAS float* rs_lds;
    __device__ __forceinline__ void operator()(const f32x4 (&acc)[2][2][4][2], const Unit& u, int wr, int wc, int fr, int fq) const {
        const int row0 = u.pm * BM + wr * 64 + fr; const int colt = u.pn * BM;
        const int col0 = colt + wc * 32 + 8 * fq;
        const bool is_g = colt >= g_begin; const float sc = colt < q_end ? qscale : 1.0f;
#pragma unroll
        for (int ai = 0; ai < 2; ++ai)
#pragma unroll
            for (int m = 0; m < 4; ++m) { bf16_t* rowp = O + (size_t)(row0 + ai * HALF + m * 16) * ldc + col0;
                const float rs = rs_lds ? rs_lds[((u.pm >> 3) & 1) * 256 + wr * 64 + fr + ai * HALF + m * 16] * sc : (rstd ? sc / sqrtf(slot_sum8(rstd + (size_t)(row0 + ai * HALF + m * 16) * 8) * (1.0f / 2048.0f) + 1e-6f) : sc);
#pragma unroll
                for (int bj = 0; bj < 2; ++bj) { f32x4 v0 = acc[ai][bj][m][0] * rs, v1 = acc[ai][bj][m][1] * rs;
                    if (is_g) {
#pragma unroll
                        for (int j = 0; j < 4; ++j) { v0[j] = v0[j] * __builtin_amdgcn_rcpf(1.0f + __builtin_amdgcn_exp2f(-1.4426950408889634f * v0[j])); v1[j] = v1[j] * __builtin_amdgcn_rcpf(1.0f + __builtin_amdgcn_exp2f(-1.4426950408889634f * v1[j])); } }
                    u32x4 w; w.x = cvt2(v0[0], v0[1]); w.y = cvt2(v0[2], v0[3]); w.z = cvt2(v1[0], v1[1]); w.w = cvt2(v1[2], v1[3]);
                    __builtin_nontemporal_store(w, (u32x4*)(rowp + bj * HALF)); } }
    }
};
struct PanelOrder {
    int c;
    __device__ __forceinline__ bool next(int i, Unit& u) const { if (i >= 4) return false; const int x = c & 7, j = c >> 3; u.pm = 16 * x + 4 * i + (j >> 3); u.pn = j & 7; return true; }
    __device__ __forceinline__ void a_ready(const Unit&) const {}
    __device__ __forceinline__ void done(const Unit&) const {}
};
constexpr size_t FUSE_XB = (size_t)832 << 20, FUSE_XS = (size_t)960 << 20, FUSE_YS = (size_t)157 << 20, FUSE_CNT = ((size_t)156 << 20) + 65536;
struct EpiFuse {
    static constexpr bool PERM = true, AFTER_DRAIN = false;
    unsigned char* wsb; float* out32; const float* gpost; int layer; PG8_LAS float* P;
    __device__ __forceinline__ void operator()(const f32x4 (&acc)[2][2][4][2], const Unit& u, int wr, int wc, int fr, int fq) const {
        bf16_t* XBp = (bf16_t*)(wsb + FUSE_XB); float* ys = (float*)(wsb + FUSE_YS); float* xs_next = layer < 3 ? (float*)(wsb + FUSE_XS) + (size_t)(layer + 1) * 32768 * 8 : nullptr; unsigned* cnt = (unsigned*)(wsb + FUSE_CNT) + (size_t)layer * 128 * 64;
        const int rp0 = wr * 64 + fr, row0 = u.pm * BM + rp0, col0 = u.pn * BM + wc * 32 + 8 * fq, tid = threadIdx.x;
        PG8_LAS float* S = P + 1024;
#pragma unroll
        for (int ai = 0; ai < 2; ++ai)
#pragma unroll
            for (int m = 0; m < 4; ++m) { float s = 0.f;
#pragma unroll
                for (int bj = 0; bj < 2; ++bj)
#pragma unroll
                    for (int n = 0; n < 2; ++n) { const f32x4 x = acc[ai][bj][m][n]; s += (x[0] * x[0] + x[1] * x[1]) + (x[2] * x[2] + x[3] * x[3]); }
                s += __shfl_xor(s, 16); s += __shfl_xor(s, 32);
                if (fq == 0) P[(rp0 + ai * HALF + m * 16) * 4 + wc] = s; }
        asm volatile("s_waitcnt lgkmcnt(0)" ::: "memory"); __builtin_amdgcn_s_barrier(); asm volatile("" ::: "memory");
        if (tid < 256) { const float t4 = (P[tid * 4 + 0] + P[tid * 4 + 1]) + (P[tid * 4 + 2] + P[tid * 4 + 3]);
            __hip_atomic_store(ys + (size_t)(u.pm * BM + tid) * 8 + u.pn, t4, __ATOMIC_RELAXED, __HIP_MEMORY_SCOPE_AGENT); }
        asm volatile("s_waitcnt vmcnt(0)" ::: "memory");
        unsigned* cw = cnt + 64 * u.pm;
        if ((tid & 63) == 0) (void)__hip_atomic_fetch_add(cw, 1u, __ATOMIC_RELAXED, __HIP_MEMORY_SCOPE_AGENT);
        { unsigned spins = 0;
          while ((unsigned)__builtin_amdgcn_readfirstlane(__hip_atomic_load(cw, __ATOMIC_RELAXED, __HIP_MEMORY_SCOPE_AGENT)) < 64u) { __builtin_amdgcn_s_sleep(2); if (++spins > (1u << 22)) break; } }
        asm volatile("" ::: "memory");
        if (tid < 256) { const float* sl = ys + (size_t)(u.pm * BM + tid) * 8; float t8 = 0.f;
#pragma unroll
            for (int q = 0; q < 8; ++q) t8 += __hip_atomic_load(sl + q, __ATOMIC_RELAXED, __HIP_MEMORY_SCOPE_AGENT);
            S[tid] = 1.0f / sqrtf(t8 * (1.0f / 2048.0f) + 1e-6f); }
        asm volatile("s_waitcnt vmcnt(0) lgkmcnt(0)" ::: "memory"); __builtin_amdgcn_s_barrier(); asm volatile("" ::: "memory");
        float g[2][8];
#pragma unroll
        for (int bj = 0; bj < 2; ++bj) { const f32x4 a = *(const f32x4*)(gpost + col0 + bj * HALF), b = *(const f32x4*)(gpost + col0 + bj * HALF + 4);
            g[bj][0] = a[0]; g[bj][1] = a[1]; g[bj][2] = a[2]; g[bj][3] = a[3]; g[bj][4] = b[0]; g[bj][5] = b[1]; g[bj][6] = b[2]; g[bj][7] = b[3]; }
#pragma unroll
        for (int ai = 0; ai < 2; ++ai) {
            u32x4 xw[4][2];
#pragma unroll
            for (int m = 0; m < 4; ++m)
#pragma unroll
                for (int bj = 0; bj < 2; ++bj) xw[m][bj] = *(const u32x4*)(XBp + (size_t)(u.pm * BM + rp0 + ai * HALF + m * 16) * 2048 + col0 + bj * HALF);
#pragma unroll
            for (int m = 0; m < 4; ++m) { const int rp = rp0 + ai * HALF + m * 16, row = u.pm * BM + rp;
                const float ry = S[rp];
                float s2 = 0.f;
#pragma unroll
                for (int bj = 0; bj < 2; ++bj) { bf16_t* xp = XBp + (size_t)row * 2048 + col0 + bj * HALF;
                    const u32x4 xv = xw[m][bj]; float o[8];
                    o[0] = __uint_as_float(xv.x << 16); o[1] = __uint_as_float(xv.x & 0xffff0000u); o[2] = __uint_as_float(xv.y << 16); o[3] = __uint_as_float(xv.y & 0xffff0000u);
                    o[4] = __uint_as_float(xv.z << 16); o[5] = __uint_as_float(xv.z & 0xffff0000u); o[6] = __uint_as_float(xv.w << 16); o[7] = __uint_as_float(xv.w & 0xffff0000u);
#pragma unroll
                    for (int e = 0; e < 8; ++e) { o[e] += acc[ai][bj][m][e >> 2][e & 3] * ry * g[bj][e]; s2 += o[e] * o[e]; }
                    if (out32) { float* op = out32 + (size_t)row * 2048 + col0 + bj * HALF; *(f32x4*)op = (f32x4){o[0], o[1], o[2], o[3]}; *(f32x4*)(op + 4) = (f32x4){o[4], o[5], o[6], o[7]}; }
                    else { u32x4 w; w.x = cvt2(o[0], o[1]); w.y = cvt2(o[2], o[3]); w.z = cvt2(o[4], o[5]); w.w = cvt2(o[6], o[7]); *(u32x4*)xp = w; } }
                if (xs_next) { s2 += __shfl_xor(s2, 16); s2 += __shfl_xor(s2, 32); if (fq == 0) P[rp * 4 + wc] = s2; } }
            asm volatile("" ::: "memory");
        }
        if (xs_next) {
            asm volatile("s_waitcnt lgkmcnt(0)" ::: "memory"); __builtin_amdgcn_s_barrier(); asm volatile("" ::: "memory");
            if (tid < 256) xs_next[(size_t)(u.pm * BM + tid) * 8 + u.pn] = (P[tid * 4 + 0] + P[tid * 4 + 1]) + (P[tid * 4 + 2] + P[tid * 4 + 3]);
            asm volatile("s_waitcnt lgkmcnt(0)" ::: "memory"); __builtin_amdgcn_s_barrier(); asm volatile("" ::: "memory");
        }
    }
};
template <class Epi, class Sched, bool ALIGN_EPI = false, bool SP2 = false>
__device__ __forceinline__ void gemm_phase2(PG8_LAS unsigned char* lds, const Gemm g, const Sched& S, const Epi& E, const int tid_in) {
    const int tid = tid_in, wid = __builtin_amdgcn_readfirstlane(tid >> 6), lane = tid & 63, wr = wid >> 2, wc = wid & 3, fr = lane & 15, fq = lane >> 4;
    const int K = g.K, nt = K / BK;
    unsigned voffA[2], voffB[2];
#pragma unroll
    for (int i = 0; i < 2; ++i) { int R, C; stage_rc(tid * 16 + i * 8192, R, C); const int Rb = Epi::PERM ? ((R & ~31) + perm32(R & 31)) : R;
        voffA[i] = (unsigned)(R * K + C) * 2u; voffB[i] = (unsigned)(Rb * K + C) * 2u; }
    const size_t kstep = (size_t)(BK * 2);
    const size_t hstep = (size_t)HALF * K * 2;
    const size_t tstep = 2 * hstep;
    const unsigned ldsw = (unsigned)wid * 1024u;
    const int aoff = lds_byte(wr * 64 + fr, fq * 8), boff = lds_byte(wc * 32 + fr, fq * 8);
#define PG8_SA(b, h) (((b) * 2 + (h)) * HTB)
#define PG8_SB(b, h) ((4 + (b) * 2 + (h)) * HTB)
#define PG8_STAGE(bufoff, gbase, voff) do { _Pragma("unroll") for (int _i = 0; _i < 2; ++_i) \
        __builtin_amdgcn_global_load_lds((const unsigned*)((const char*)(gbase) + (voff)[_i]), (PG8_LAS unsigned*)(lds + (bufoff) + ldsw + _i * 8192), 16, 0, 0); } while (0)
#define PG8_LDA(dst, b, h) do { _Pragma("unroll") for (int m = 0; m < 4; ++m) _Pragma("unroll") for (int k = 0; k < 2; ++k) dst[m][k] = *(const PG8_LAS bf16x8*)(lds + PG8_SA(b, h) + aoff + m * 2048 + k * 1024); } while (0)
#define PG8_LDB(dst, b, h) do { _Pragma("unroll") for (int n = 0; n < 2; ++n) _Pragma("unroll") for (int k = 0; k < 2; ++k) dst[n][k] = *(const PG8_LAS bf16x8*)(lds + PG8_SB(b, h) + boff + n * 2048 + k * 1024); } while (0)
#define PG8_MMA(ai, bj, At, Bt) do { __builtin_amdgcn_s_setprio(1); _Pragma("unroll") for (int m = 0; m < 4; ++m) _Pragma("unroll") for (int n = 0; n < 2; ++n) _Pragma("unroll") for (int k = 0; k < 2; ++k) \
        acc[ai][bj][m][n] = __builtin_amdgcn_mfma_f32_16x16x32_bf16(Bt[n][k], At[m][k], acc[ai][bj][m][n], 0, 0, 0); __builtin_amdgcn_s_setprio(0); } while (0)
#define PG8_WAIT_V(n) asm volatile("s_waitcnt vmcnt(" #n ")" ::: "memory")
#define PG8_WAIT_L(n) asm volatile("s_waitcnt lgkmcnt(" #n ")" ::: "memory")
#define PG8_BAR __builtin_amdgcn_s_barrier()
#define PG8_SCHED __builtin_amdgcn_sched_barrier(0)
    Unit cur, nxt; int ui = 0;
    if (!S.next(0, cur)) return;
    f32x4 acc[2][2][4][2];
#pragma unroll
    for (int a = 0; a < 2; ++a)
#pragma unroll
        for (int b = 0; b < 2; ++b)
#pragma unroll
            for (int m = 0; m < 4; ++m)
#pragma unroll
                for (int n = 0; n < 2; ++n) acc[a][b][m][n] = (f32x4){0.f, 0.f, 0.f, 0.f};
    bf16x8 At[4][2], B0[2][2], B1[2][2];
    const char* cA = (const char*)g.A + (size_t)cur.pm * tstep; const char* cB = (const char*)g.Bt + (size_t)cur.pn * tstep;
    S.a_ready(cur);
    if constexpr (SP2) {
        PG8_STAGE(PG8_SB(0, 0), cB, voffB); PG8_STAGE(PG8_SB(0, 1), cB + hstep, voffB); PG8_STAGE(PG8_SA(0, 0), cA, voffA); PG8_STAGE(PG8_SA(0, 1), cA + hstep, voffA);
        if (wr == 1) PG8_BAR;
        PG8_WAIT_V(2); PG8_BAR;
        PG8_STAGE(PG8_SB(1, 0), cB + kstep, voffB); PG8_STAGE(PG8_SA(1, 0), cA + kstep, voffA); PG8_STAGE(PG8_SB(1, 1), cB + hstep + kstep, voffB);
        PG8_WAIT_V(6); PG8_BAR;
    } else {
        PG8_STAGE(PG8_SB(0, 0), cB, voffB); PG8_STAGE(PG8_SA(0, 0), cA, voffA); PG8_STAGE(PG8_SB(0, 1), cB + hstep, voffB); PG8_STAGE(PG8_SA(0, 1), cA + hstep, voffA);
        if (wr == 1) PG8_BAR;
        PG8_WAIT_V(4); PG8_BAR;
        PG8_STAGE(PG8_SB(1, 0), cB + kstep, voffB); PG8_STAGE(PG8_SA(1, 0), cA + kstep, voffA); PG8_STAGE(PG8_SB(1, 1), cB + hstep + kstep, voffB);
        PG8_WAIT_V(6); PG8_BAR;
    }
    for (;;) {
        const bool has_next = S.next(ui + 1, nxt);
        const char* nA = has_next ? (const char*)g.A + (size_t)nxt.pm * tstep : cA; const char* nB = has_next ? (const char*)g.Bt + (size_t)nxt.pn * tstep : cB;
        for (int t = 0; t < nt; t += 2) {
            const bool last = (t == nt - 2);
            const char* a1 = cA + (size_t)(t + 1) * kstep;
            const char* a2 = last ? nA : cA + (size_t)(t + 2) * kstep; const char* b2 = last ? nB : cB + (size_t)(t + 2) * kstep;
            const char* a3 = a2 + kstep; const char* b3 = b2 + kstep;
            if (last && has_next) S.a_ready(nxt);
            if constexpr (SP2) {
            PG8_LDB(B0, 0, 0); PG8_LDB(B1, 0, 1); PG8_SCHED; PG8_LDA(At, 0, 0); PG8_STAGE(PG8_SA(1, 1), a1 + hstep, voffA);
            PG8_WAIT_V(8); PG8_WAIT_L(0); PG8_BAR; PG8_MMA(0, 0, At, B0); PG8_MMA(0, 1, At, B1); PG8_BAR; PG8_SCHED;
            PG8_LDA(At, 0, 1); PG8_STAGE(PG8_SB(0, 0), b2, voffB); PG8_STAGE(PG8_SB(0, 1), b2 + hstep, voffB); PG8_STAGE(PG8_SA(0, 0), a2, voffA);
            PG8_WAIT_V(8); PG8_WAIT_L(0); PG8_BAR; PG8_MMA(1, 0, At, B0); PG8_MMA(1, 1, At, B1); PG8_BAR; PG8_SCHED;
            PG8_LDB(B0, 1, 0); PG8_LDB(B1, 1, 1); PG8_SCHED; PG8_LDA(At, 1, 0); PG8_STAGE(PG8_SA(0, 1), a2 + hstep, voffA);
            PG8_WAIT_V(8); PG8_WAIT_L(0); PG8_BAR; PG8_MMA(0, 0, At, B0); PG8_MMA(0, 1, At, B1); PG8_BAR; PG8_SCHED;
            PG8_LDA(At, 1, 1); PG8_STAGE(PG8_SB(1, 0), b3, voffB); PG8_STAGE(PG8_SB(1, 1), b3 + hstep, voffB); PG8_STAGE(PG8_SA(1, 0), a3, voffA);
            PG8_WAIT_V(8); PG8_WAIT_L(0); PG8_BAR; PG8_MMA(1, 0, At, B0); PG8_MMA(1, 1, At, B1); PG8_BAR; PG8_SCHED;
            } else {
            PG8_LDB(B0, 0, 0); PG8_SCHED; PG8_LDA(At, 0, 0); PG8_STAGE(PG8_SA(1, 1), a1 + hstep, voffA);
            PG8_WAIT_L(8); PG8_BAR; PG8_WAIT_L(0); PG8_MMA(0, 0, At, B0); PG8_BAR; PG8_SCHED;
            PG8_LDB(B1, 0, 1); PG8_STAGE(PG8_SB(0, 0), b2, voffB);
            PG8_BAR; PG8_WAIT_L(0); PG8_MMA(0, 1, At, B1); PG8_BAR;
            PG8_LDA(At, 0, 1); PG8_STAGE(PG8_SA(0, 0), a2, voffA);
            PG8_BAR; PG8_WAIT_L(0); PG8_MMA(1, 0, At, B0); PG8_BAR; PG8_SCHED;
            PG8_STAGE(PG8_SB(0, 1), b2 + hstep, voffB);
            PG8_WAIT_V(6); PG8_BAR; PG8_MMA(1, 1, At, B1); PG8_BAR;
            PG8_LDB(B0, 1, 0); PG8_SCHED; PG8_LDA(At, 1, 0); PG8_STAGE(PG8_SA(0, 1), a2 + hstep, voffA);
            PG8_WAIT_L(8); PG8_BAR; PG8_WAIT_L(0); PG8_MMA(0, 0, At, B0); PG8_BAR; PG8_SCHED;
            PG8_LDB(B1, 1, 1); PG8_STAGE(PG8_SB(1, 0), b3, voffB);
            PG8_BAR; PG8_WAIT_L(0); PG8_MMA(0, 1, At, B1); PG8_BAR;
            PG8_LDA(At, 1, 1); PG8_STAGE(PG8_SA(1, 0), a3, voffA);
            PG8_BAR; PG8_WAIT_L(0); PG8_MMA(1, 0, At, B0); PG8_BAR; PG8_SCHED;
            PG8_STAGE(PG8_SB(1, 1), b3 + hstep, voffB);
            PG8_WAIT_V(6); PG8_BAR; PG8_MMA(1, 1, At, B1); PG8_BAR;
            }
        }
        if constexpr (ALIGN_EPI) { if (wr == 0) PG8_BAR; }
        if constexpr (!Epi::AFTER_DRAIN) { E(acc, cur, wr, wc, fr, fq); S.done(cur); }
        if (!has_next) break;
#pragma unroll
        for (int a = 0; a < 2; ++a)
#pragma unroll
            for (int b = 0; b < 2; ++b)
#pragma unroll
                for (int m = 0; m < 4; ++m)
#pragma unroll
                    for (int n = 0; n < 2; ++n) acc[a][b][m][n] = (f32x4){0.f, 0.f, 0.f, 0.f};
        cur = nxt; cA = nA; cB = nB; ++ui;
        if constexpr (ALIGN_EPI) { if (wr == 1) PG8_BAR; }
    }
    PG8_WAIT_V(0);
    if constexpr (!ALIGN_EPI) { if (wr == 0) PG8_BAR; }
    PG8_BAR;
    if constexpr (Epi::AFTER_DRAIN) { E.fused(acc, cur, wr, wc, fr, fq, lds, wid, lane); S.done(cur); }
#undef PG8_SA
#undef PG8_SB
#undef PG8_STAGE
#undef PG8_LDA
#undef PG8_LDB
#undef PG8_MMA
#undef PG8_WAIT_V
#undef PG8_WAIT_L
#undef PG8_BAR
#undef PG8_SCHED
}

}

__device__ __forceinline__ void transpose_item(const float* W, int ldw, int nblk, int K, bf16_t* WT, LAS float* scr, int item, int lane, const float* g) {
    const int kb = item / nblk, nb = item - kb * nblk, k0 = 64 * kb, n0 = 32 * nb;
#pragma unroll
    for (int i = 0; i < 8; ++i) { const int kk = 8 * i + (lane >> 3), q = lane & 7;
        const f32x4 v = *(const f32x4*)(W + (size_t)(k0 + kk) * ldw + n0 + 4 * q); LAS float* d = scr + kk * 33 + 4 * q; d[0] = v.x; d[1] = v.y; d[2] = v.z; d[3] = v.w; }
    asm volatile("s_waitcnt lgkmcnt(0)" ::: "memory");
    const int c = lane & 7;
    f32x4 ga = {1.f, 1.f, 1.f, 1.f}, gb = ga;
    if (g) { ga = *(const f32x4*)(g + k0 + 8 * c); gb = *(const f32x4*)(g + k0 + 8 * c + 4); }
#pragma unroll
    for (int j = 0; j < 4; ++j) { const int n = (lane >> 3) + 8 * j; const LAS float* s = scr + (8 * c) * 33 + n;
        u32x4 o; o.x = pk2(s[0 * 33] * ga[0], s[1 * 33] * ga[1]); o.y = pk2(s[2 * 33] * ga[2], s[3 * 33] * ga[3]); o.z = pk2(s[4 * 33] * gb[0], s[5 * 33] * gb[1]); o.w = pk2(s[6 * 33] * gb[2], s[7 * 33] * gb[3]);
        *(u32x4*)(WT + (size_t)(n0 + n) * K + k0 + 8 * c) = o; }
    asm volatile("s_waitcnt lgkmcnt(0)" ::: "memory");
}
__device__ __forceinline__ void norm_row_to_bf16(const float* xrow, float* rstd_out, bf16_t* orow, int lane) {
    f32x4 v[4][2]; float s = 0.f;
#pragma unroll
    for (int j = 0; j < 4; ++j)
#pragma unroll
        for (int q = 0; q < 2; ++q) { v[j][q] = *(const f32x4*)(xrow + 8 * lane + 512 * j + 4 * q); s += (v[j][q].x * v[j][q].x + v[j][q].y * v[j][q].y) + (v[j][q].z * v[j][q].z + v[j][q].w * v[j][q].w); }
    const float ssq = wave_sum(s);
    float zz = 0.f; asm volatile("" : "+v"(zz));
    if (lane == 0) { *(f32x4*)rstd_out = (f32x4){ssq, zz, zz, zz}; *(f32x4*)(rstd_out + 4) = (f32x4){zz, zz, zz, zz}; }
#pragma unroll
    for (int j = 0; j < 4; ++j) { u32x4 w; w.x = pk2(v[j][0].x, v[j][0].y); w.y = pk2(v[j][0].z, v[j][0].w); w.z = pk2(v[j][1].x, v[j][1].y); w.w = pk2(v[j][1].z, v[j][1].w);
        *(u32x4*)(orow + 8 * lane + 512 * j) = w; }
}
__device__ __forceinline__ void prologue_phase(const Params& p, LAS unsigned char* L, int G, int blk, int wave, int lane) {
    LAS float* scr = (LAS float*)(L + wave * 16384);
    const int gw = blk * 8 + wave, NGW = G * 8;
    unsigned char* ws = p.ws;
    constexpr int I_AIN = 32 * 256, I_AOUT = 32 * 64, I_BIN = 32 * 160, I_BOUT = 40 * 64, I_CIN = 32 * 256, I_COUT = 32 * 64;
    constexpr int NITEMS = 2 * I_AIN + 2 * I_AOUT + I_BIN + I_BOUT + I_CIN + I_COUT;
    for (int it = gw; it < NITEMS; it += NGW) {
        int r = it;
        if (r < I_AIN) { transpose_item(p.in[3], NA, 256, DM, (bf16_t*)(ws + WS_WA_IN), scr, r, lane, p.in[1]); continue; } r -= I_AIN;
        if (r < I_AOUT) { transpose_item(p.in[5], DM, 64, DM, (bf16_t*)(ws + WS_WA_OUT), scr, r, lane, nullptr); continue; } r -= I_AOUT;
        if (r < I_BIN) { transpose_item(p.in[6], NBP, 160, DM, (bf16_t*)(ws + WS_WB_IN), scr, r, lane, p.in[1] + DM); continue; } r -= I_BIN;
        if (r < I_BOUT) { transpose_item(p.in[14], DM, 64, RGW, (bf16_t*)(ws + WS_WB_OUT), scr, r, lane, nullptr); continue; } r -= I_BOUT;
        if (r < I_CIN) { transpose_item(p.in[15], NCF, 256, DM, (bf16_t*)(ws + WS_WC_IN), scr, r, lane, p.in[1] + 2 * DM); continue; } r -= I_CIN;
        if (r < I_COUT) { transpose_item(p.in[17], DM, 64, DM, (bf16_t*)(ws + WS_WC_OUT), scr, r, lane, nullptr); continue; } r -= I_COUT;
        if (r < I_AIN) { transpose_item(p.in[3] + (size_t)DM * NA, NA, 256, DM, (bf16_t*)(ws + WS_WA_IN + 32 * MiB), scr, r, lane, p.in[1] + 3 * DM); continue; } r -= I_AIN;
        transpose_item(p.in[5] + (size_t)DM * DM, DM, 64, DM, (bf16_t*)(ws + WS_WA_OUT + 8 * MiB), scr, r, lane, nullptr);
    }
    for (int it = gw * 64 + lane; it < 2 * 16 * 10 * 5 * 64; it += NGW * 64) { const int l = it & 63, f = it >> 6, ks = f % 5, ct = (f / 5) % 10, nb = (f / 50) % 16, gate = f / 800;
        const float* src = (gate ? p.in[11] : p.in[9]) + (size_t)nb * 25600 + (32 * ks + 8 * (l >> 4)) * 160 + ct * 16 + (l & 15);
        u32x4 o; o.x = pk2(src[0], src[160]); o.y = pk2(src[320], src[480]); o.z = pk2(src[640], src[800]); o.w = pk2(src[960], src[1120]);
        *(u32x4*)(ws + WS_GW + (size_t)it * 16) = o; }
    bf16_t* XB = (bf16_t*)(ws + WS_XB); float* RSTD = (float*)(ws + WS_XS);
    for (int m = gw; m < MTOK; m += NGW) norm_row_to_bf16(p.in[0] + (size_t)m * DM, RSTD + (size_t)m * 8, XB + (size_t)m * DM, lane);
}

__device__ __forceinline__ void unpack8(const u32x4 w, float (&o)[8]) { o[0] = bflo(w.x); o[1] = bfhi(w.x); o[2] = bflo(w.y); o[3] = bfhi(w.y); o[4] = bflo(w.z); o[5] = bfhi(w.z); o[6] = bflo(w.w); o[7] = bfhi(w.w); }
template <int NR, bool XF32>
__device__ __forceinline__ void row_phase(const bf16_t* Y, const float* xin32, bf16_t* XB, float* out32, const float* gpost, float* RSTD, const float* gpre,
                                          const float* wf, const float* fbias, float* LOGF, int gw, int NGW, int lane, LAS float* WL, int tid) {
    if (wf) {
        for (int i = tid; i < DM * 4; i += 512) { const int d = i >> 2, q = i & 3; const f32x4 v4 = *(const f32x4*)(wf + (size_t)d * NCF + 4 * q);
            const int slot = (((d >> 9) * 8 + (d & 7)) * 64 + ((d & 511) >> 3)); *(LAS f32x4*)(WL + slot * 16 + 4 * q) = v4; }
        __syncthreads();
    }
    float gp[4][8];
#pragma unroll
    for (int j = 0; j < 4; ++j) { const f32x4 a = *(const f32x4*)(gpost + 8 * lane + 512 * j), b = *(const f32x4*)(gpost + 8 * lane + 512 * j + 4);
        gp[j][0] = a.x; gp[j][1] = a.y; gp[j][2] = a.z; gp[j][3] = a.w; gp[j][4] = b.x; gp[j][5] = b.y; gp[j][6] = b.z; gp[j][7] = b.w; }
    for (int m0 = gw; m0 < MTOK; m0 += NGW * NR) {
        u32x4 yw[NR][4], xw[XF32 ? 1 : NR][4]; f32x4 xf[XF32 ? NR : 1][4][2];
#pragma unroll
        for (int r = 0; r < NR; ++r) { const int m = m0 + r * NGW;
            if (m < MTOK) {
#pragma unroll
                for (int j = 0; j < 4; ++j) yw[r][j] = *(const u32x4*)(Y + (size_t)m * DM + 8 * lane + 512 * j);
                if (XF32) {
#pragma unroll
                    for (int j = 0; j < 4; ++j) { xf[XF32 ? r : 0][j][0] = *(const f32x4*)(xin32 + (size_t)m * DM + 8 * lane + 512 * j); xf[XF32 ? r : 0][j][1] = *(const f32x4*)(xin32 + (size_t)m * DM + 8 * lane + 512 * j + 4); }
                } else {
#pragma unroll
                    for (int j = 0; j < 4; ++j) xw[XF32 ? 0 : r][j] = *(const u32x4*)(XB + (size_t)m * DM + 8 * lane + 512 * j);
                } } }
#pragma unroll
        for (int r = 0; r < NR; ++r) { const int m = m0 + r * NGW; if (m >= MTOK) break;
            float v[4][8]; float s = 0.f;
#pragma unroll
            for (int j = 0; j < 4; ++j) { unpack8(yw[r][j], v[j]);
#pragma unroll
                for (int e = 0; e < 8; ++e) s += v[j][e] * v[j][e]; }
            const float rstd_y = 1.0f / sqrtf(wave_sum(s) * (1.0f / DM) + RMS_EPS);
            float s2 = 0.f;
#pragma unroll
            for (int j = 0; j < 4; ++j) { float xx[8];
                if (XF32) { const int rr = XF32 ? r : 0; xx[0] = xf[rr][j][0].x; xx[1] = xf[rr][j][0].y; xx[2] = xf[rr][j][0].z; xx[3] = xf[rr][j][0].w; xx[4] = xf[rr][j][1].x; xx[5] = xf[rr][j][1].y; xx[6] = xf[rr][j][1].z; xx[7] = xf[rr][j][1].w; }
                else unpack8(xw[XF32 ? 0 : r][j], xx);
#pragma unroll
                for (int e = 0; e < 8; ++e) { v[j][e] = xx[e] + v[j][e] * rstd_y * gp[j][e]; s2 += v[j][e] * v[j][e]; } }
            if (out32) {
#pragma unroll
                for (int j = 0; j < 4; ++j) { *(f32x4*)(out32 + (size_t)m * DM + 8 * lane + 512 * j) = (f32x4){v[j][0], v[j][1], v[j][2], v[j][3]}; *(f32x4*)(out32 + (size_t)m * DM + 8 * lane + 512 * j + 4) = (f32x4){v[j][4], v[j][5], v[j][6], v[j][7]}; }
            } else {
                const float ssq2 = wave_sum(s2); const float rstd = 1.0f / sqrtf(ssq2 * (1.0f / DM) + RMS_EPS);
                if (lane == 0) { *(f32x4*)(RSTD + (size_t)m * 8) = (f32x4){ssq2, 0.f, 0.f, 0.f}; *(f32x4*)(RSTD + (size_t)m * 8 + 4) = (f32x4){0.f, 0.f, 0.f, 0.f}; }
#pragma unroll
                for (int j = 0; j < 4; ++j) { u32x4 w; w.x = pk2(v[j][0], v[j][1]); w.y = pk2(v[j][2], v[j][3]); w.z = pk2(v[j][4], v[j][5]); w.w = pk2(v[j][6], v[j][7]); *(u32x4*)(XB + (size_t)m * DM + 8 * lane + 512 * j) = w; }
                if (wf) {
                    f32x4 a0 = {0.f, 0.f, 0.f, 0.f}, a1 = a0, a2 = a0, a3 = a0;
                    int lo = lane; asm volatile("" : "+v"(lo));
#pragma unroll
                    for (int j = 0; j < 4; ++j)
#pragma unroll
                        for (int e = 0; e < 8; ++e) { const int d = 8 * lo + 512 * j + e; const LAS f32x4* wp = (const LAS f32x4*)(WL + ((j * 8 + e) * 64 + lo) * 16); const float hv = v[j][e] * rstd * gpre[d];
                            a0 += wp[0] * hv; a1 += wp[1] * hv; a2 += wp[2] * hv; a3 += wp[3] * hv;
                            if ((e & 3) == 3) asm volatile("" ::: "memory"); }
                    float mine = 0.f;
#pragma unroll
                    for (int q = 0; q < 4; ++q) { const float t0 = wave_sum(a0[q]), t1 = wave_sum(a1[q]), t2 = wave_sum(a2[q]), t3 = wave_sum(a3[q]);
                        mine = lane == q ? t0 : mine; mine = lane == 4 + q ? t1 : mine; mine = lane == 8 + q ? t2 : mine; mine = lane == 12 + q ? t3 : mine; }
                    if (lane < 16) { const float z = mine + fbias[lane]; const float lf = fminf(z, 0.f) - log1pexp_neg_abs(z); LOGF[(size_t)m * 16 + lane] = lf; }
                }
            }
        }
    }
}

__device__ __forceinline__ void flogit_phase(const bf16_t* XB, const float* xs, const float* gpre, const float* wf, const float* fbias, float* LOGF, int gw, int NGW, int lane, LAS float* WL, int tid) {
    for (int i = tid; i < DM * 4; i += 512) { const int d = i >> 2, q = i & 3; const f32x4 v4 = *(const f32x4*)(wf + (size_t)d * NCF + 4 * q);
        const int slot = (((d >> 9) * 8 + (d & 7)) * 64 + ((d & 511) >> 3)); *(LAS f32x4*)(WL + slot * 16 + 4 * q) = v4; }
    __syncthreads();
    float gp[4][8];
#pragma unroll
    for (int j = 0; j < 4; ++j) { const f32x4 a = *(const f32x4*)(gpre + 8 * lane + 512 * j), b = *(const f32x4*)(gpre + 8 * lane + 512 * j + 4);
        gp[j][0] = a.x; gp[j][1] = a.y; gp[j][2] = a.z; gp[j][3] = a.w; gp[j][4] = b.x; gp[j][5] = b.y; gp[j][6] = b.z; gp[j][7] = b.w; }
    for (int m = gw; m < MTOK; m += NGW) {
        u32x4 xw[4];
#pragma unroll
        for (int j = 0; j < 4; ++j) xw[j] = *(const u32x4*)(XB + (size_t)m * DM + 8 * lane + 512 * j);
        const float rstd = 1.0f / sqrtf(pg8::slot_sum8(xs + (size_t)m * 8) * (1.0f / DM) + RMS_EPS);
        f32x4 a0 = {0.f, 0.f, 0.f, 0.f}, a1 = a0, a2 = a0, a3 = a0;
        int lo = lane; asm volatile("" : "+v"(lo));
#pragma unroll
        for (int j = 0; j < 4; ++j) { float v[8]; unpack8(xw[j], v);
#pragma unroll
            for (int e = 0; e < 8; ++e) { const LAS f32x4* wp = (const LAS f32x4*)(WL + ((j * 8 + e) * 64 + lo) * 16); const float hv = v[e] * rstd * gp[j][e];
                a0 += wp[0] * hv; a1 += wp[1] * hv; a2 += wp[2] * hv; a3 += wp[3] * hv;
                if ((e & 3) == 3) asm volatile("" ::: "memory"); } }
        float mine = 0.f;
#pragma unroll
        for (int q = 0; q < 4; ++q) { const float t0 = wave_sum(a0[q]), t1 = wave_sum(a1[q]), t2 = wave_sum(a2[q]), t3 = wave_sum(a3[q]);
            mine = lane == q ? t0 : mine; mine = lane == 4 + q ? t1 : mine; mine = lane == 8 + q ? t2 : mine; mine = lane == 12 + q ? t3 : mine; }
        if (lane < 16) { const float z = mine + fbias[lane]; const float lf = fminf(z, 0.f) - log1pexp_neg_abs(z); LOGF[(size_t)m * 16 + lane] = lf; }
    }
}

__device__ __forceinline__ void cumsum_phase(const float* LOGF, float* CUMB, LAS float* sc, int G, int blk, int tid) {
    const int lane = tid & 63, wave = tid >> 6;
    for (int bh = blk; bh < NBATCH * NHEAD; bh += G) {
        const int b = bh >> 4, hh = bh & 15; const int t0 = 4 * tid;
        float v[4];
#pragma unroll
        for (int e = 0; e < 4; ++e) v[e] = LOGF[((size_t)(b * SEQ + t0 + e)) * 16 + hh];
        v[1] += v[0]; v[2] += v[1]; v[3] += v[2];
        float incl = v[3];
#pragma unroll
        for (int o = 1; o < 64; o <<= 1) { const float t = __shfl_up(incl, o); if (lane >= o) incl += t; }
        if (lane == 63) sc[wave] = incl;
        __syncthreads();
        float woff = 0.f;
        for (int i = 0; i < wave; ++i) woff += sc[i];
        const float excl = incl - v[3] + woff;
        f32x4 o; o.x = -(excl + v[0]) * LOG2E; o.y = -(excl + v[1]) * LOG2E; o.z = -(excl + v[2]) * LOG2E; o.w = -(excl + v[3]) * LOG2E;
        *(f32x4*)(CUMB + (size_t)bh * SEQ + t0) = o;
        __syncthreads();
    }
}

__device__ __forceinline__ unsigned off_b(unsigned row, unsigned ch) { return 256u * row + 16u * (ch ^ (((row & 3u) << 2) | ((row >> 2) & 3u))); }
#define MFMA32(a, b, c) __builtin_amdgcn_mfma_f32_32x32x16_bf16((a), (b), (c), 0, 0, 0)
template <int MODE>
__device__ __forceinline__ void attn_phase(LAS unsigned char* L, const bf16_t* PROJ, bf16_t* ACT, const float* bias_src, int G, int blk, const int tid) {
    const int  lane = tid & 63, w = __builtin_amdgcn_readfirstlane(tid >> 6), c = lane & 31, hi = lane >> 5;
    LAS float* T = (LAS float*)(L + 65536);
    const int srow = tid >> 4, sch = tid & 15;
    const unsigned soff0 = off_b(srow, sch), soff1 = off_b(srow + 32, sch);
    const unsigned kaddr = 256u * c + 16u * ((unsigned)hi ^ (((c & 3u) << 2) | ((c >> 2) & 3u)));
    const unsigned blk16 = (lane >> 4) & 1, q4 = (lane & 15) >> 2, p4 = lane & 3;
    const unsigned vbase0 = 256u * (4u * hi + q4) + 8u * (p4 & 1u);
    const unsigned vb = 64u * q4 + 16u * (((2u * blk16 + (p4 >> 1)) ^ (unsigned)hi));
    const int nit = G == 256 ? 8 : (NBATCH * NHEAD * 8 + G - 1) / G;
    for (int it = 0; it < nit; ++it) {
        int bh, qb;
        if (G == 256) { const int x = blk & 7, j = blk >> 3; bh = x * 32 + (7 - it) * 4 + (j >> 3); qb = (j + it) & 7; }
        else { const int unit = it * G + blk; if (unit >= NBATCH * NHEAD * 8) break; bh = unit & 255; qb = unit >> 8; }
        const int b = bh >> 4, h = bh & 15;
        __syncthreads();
        if (MODE == 0) { for (int i = tid; i < 639; i += 512) { int d = 575 - i; d = d < -256 ? -256 : (d > 256 ? 256 : d); T[i] = bias_src[h * NREL + d + 256] * LOG2E; } }
        else { for (int i = tid; i < (qb + 1) * 256; i += 512) T[i] = bias_src[(size_t)bh * SEQ + i]; }
        const int qrow = qb * 256 + w * 32 + c;
        const bf16_t* qp = PROJ + (size_t)(b * SEQ + qrow) * NA + h * HD + 8 * hi;
        bf16x8 qf[8];
#pragma unroll
        for (int s = 0; s < 8; ++s) qf[s] = *(const bf16x8*)(qp + 16 * s);
        const int kt_hi = 4 * qb + 3, kt_lo = MODE == 0 ? (4 * qb - 8 > 0 ? 4 * qb - 8 : 0) : 0;
        const int cw = 4 * qb + (w >> 1);
        const bf16_t* kg = PROJ + (size_t)(b * SEQ + srow) * NA + DM + h * HD + sch * 8;
        u32x4 st0, st1, st2, st3;
        { const bf16_t* g0 = kg + (size_t)kt_hi * 64 * NA;
          st0 = *(const u32x4*)g0; st1 = *(const u32x4*)(g0 + (size_t)32 * NA); st2 = *(const u32x4*)(g0 + DM); st3 = *(const u32x4*)(g0 + (size_t)32 * NA + DM); }
        *(LAS u32x4*)(L + soff0) = st0; *(LAS u32x4*)(L + soff1) = st1; *(LAS u32x4*)(L + 32768 + soff0) = st2; *(LAS u32x4*)(L + 32768 + soff1) = st3;
        f32x16 o0, o1, o2, o3;
#pragma unroll
        for (int r = 0; r < 16; ++r) { o0[r] = 0.f; o1[r] = 0.f; o2[r] = 0.f; o3[r] = 0.f; }
        float mrun = -1e30f, lrun = 0.f;
        const float cfar = MODE == 0 ? bias_src[h * NREL + 512] * LOG2E : 0.f;
#pragma unroll
        for (int s = 0; s < 8; ++s) asm volatile("" : "+v"(qf[s]));
        __syncthreads();
        int cur = 0;
        for (int kt = kt_hi; kt >= kt_lo; --kt) {
            const bool more = kt > kt_lo;
#define PREFETCH_NEXT() if (more) { const bf16_t* g0 = kg + (size_t)(kt - 1) * 64 * NA; \
                st0 = *(const u32x4*)g0; st1 = *(const u32x4*)(g0 + (size_t)32 * NA); st2 = *(const u32x4*)(g0 + DM); st3 = *(const u32x4*)(g0 + (size_t)32 * NA + DM); }
            const bool active = MODE == 0 ? (kt >= cw - 8 && kt <= cw) : (kt <= cw);
            if (active) {
                LAS unsigned char* Kb = L + cur * 16384; LAS unsigned char* Vb = L + 32768 + cur * 16384;
                unsigned kaddr_t = kaddr, vb_t = vb; asm volatile("" : "+v"(kaddr_t), "+v"(vb_t));
                unsigned va[4][2];
#pragma unroll
                for (int db = 0; db < 4; ++db)
#pragma unroll
                    for (int t = 0; t < 2; ++t) va[db][t] = vbase0 + (vb_t ^ (unsigned)(64 * db + 32 * t)) + 2048u * t;
                f32x16 s0, s1;
                if (MODE == 0) {
                    if (kt <= cw - 5) {
#pragma unroll
                        for (int r = 0; r < 16; ++r) { s0[r] = cfar; s1[r] = cfar; }
                    } else { const LAS float* tb = T + (575 - (qrow - kt * 64) + 4 * hi);
#pragma unroll
                        for (int r = 0; r < 16; ++r) { const int cr = (r & 3) + 8 * (r >> 2); s0[r] = tb[cr]; s1[r] = tb[32 + cr]; } } }
                else { const int base = kt * 64 + 4 * hi;
#pragma unroll
                    for (int r = 0; r < 16; ++r) { const int cr = (r & 3) + 8 * (r >> 2); s0[r] = T[base + cr]; s1[r] = T[base + 32 + cr]; } }
#define KLOAD(D0, D1, S) { const unsigned a_ = kaddr_t ^ (unsigned)((S) << 5); D0 = *(const LAS bf16x8*)(Kb + a_); D1 = *(const LAS bf16x8*)(Kb + a_ + 8192); }
#define QK2(A0, A1, B0, B1, S) { s0 = MFMA32(A0, qf[S], s0); s1 = MFMA32(A1, qf[S], s1); s0 = MFMA32(B0, qf[(S) + 1], s0); s1 = MFMA32(B1, qf[(S) + 1], s1); }
#define VLOAD(DST, DB) { _Pragma("unroll") for (int ks = 0; ks < 4; ++ks) { \
                    const s16x4 lo = __builtin_amdgcn_ds_read_tr16_b64_v4i16((LAS s16x4*)(Vb + va[DB][0] + 4096 * ks)); \
                    const s16x4 hh = __builtin_amdgcn_ds_read_tr16_b64_v4i16((LAS s16x4*)(Vb + va[DB][1] + 4096 * ks)); \
                    DST[ks] = __builtin_shufflevector(lo, hh, 0, 1, 2, 3, 4, 5, 6, 7); } }
#define PV4(OD, SRC) { _Pragma("unroll") for (int ks = 0; ks < 4; ++ks) OD = MFMA32(SRC[ks], pb[ks], OD); }
#define SGB_DS_MFMA(NDS) { __builtin_amdgcn_sched_group_barrier(0x100, NDS, 0); __builtin_amdgcn_sched_group_barrier(0x008, 4, 0); }
                bf16x8 ka0, ka1, ka2, ka3, kb0, kb1, kb2, kb3, vA[4], vB[4];
                KLOAD(ka0, ka1, 0) KLOAD(ka2, ka3, 1)
                __builtin_amdgcn_sched_barrier(0);
                KLOAD(kb0, kb1, 2) KLOAD(kb2, kb3, 3) QK2(ka0, ka1, ka2, ka3, 0) SGB_DS_MFMA(4)
                __builtin_amdgcn_sched_barrier(0);
                KLOAD(ka0, ka1, 4) KLOAD(ka2, ka3, 5) QK2(kb0, kb1, kb2, kb3, 2) SGB_DS_MFMA(4)
                __builtin_amdgcn_sched_barrier(0);
                KLOAD(kb0, kb1, 6) KLOAD(kb2, kb3, 7) QK2(ka0, ka1, ka2, ka3, 4) SGB_DS_MFMA(4)
                __builtin_amdgcn_sched_barrier(0);
                VLOAD(vA, 0) QK2(kb0, kb1, kb2, kb3, 6) SGB_DS_MFMA(8)
                __builtin_amdgcn_sched_barrier(0);
                PREFETCH_NEXT()
                __builtin_amdgcn_sched_barrier(0);
                if (MODE == 1 && kt == cw) {
                    const int rel = qrow - kt * 64 - 4 * hi;
#pragma unroll
                    for (int r = 0; r < 16; ++r) { const int cr = (r & 3) + 8 * (r >> 2);
                        s0[r] = cr <= rel ? s0[r] : -__builtin_inff(); s1[r] = cr + 32 <= rel ? s1[r] : -__builtin_inff(); } }
                float mx;
                { float m8[8];
#pragma unroll
                  for (int r = 0; r < 8; ++r) m8[r] = fmaxf(fmaxf(s0[r], s1[r]), fmaxf(s0[r + 8], s1[r + 8]));
                  mx = fmaxf(fmaxf(fmaxf(m8[0], m8[1]), fmaxf(m8[2], m8[3])), fmaxf(fmaxf(m8[4], m8[5]), fmaxf(m8[6], m8[7]))); }
                { const auto rr = __builtin_amdgcn_permlane32_swap(__float_as_uint(mx), __float_as_uint(mx), false, false); mx = fmaxf(__uint_as_float(rr[0]), __uint_as_float(rr[1])); }
                if (!__all(mx <= mrun + 8.0f)) {
                    const float mn = fmaxf(mrun, mx), alpha = __builtin_amdgcn_exp2f(mrun - mn); mrun = mn;
                    lrun *= alpha; o0 *= alpha; o1 *= alpha; o2 *= alpha; o3 *= alpha; }
#pragma unroll
                for (int r = 0; r < 16; ++r) { s0[r] = __builtin_amdgcn_exp2f(s0[r] - mrun); s1[r] = __builtin_amdgcn_exp2f(s1[r] - mrun); }
                { float p8[8];
#pragma unroll
                  for (int r = 0; r < 8; ++r) p8[r] = (s0[r] + s1[r]) + (s0[r + 8] + s1[r + 8]);
                  lrun += ((p8[0] + p8[1]) + (p8[2] + p8[3])) + ((p8[4] + p8[5]) + (p8[6] + p8[7])); }
                bf16x8 pb[4];
#pragma unroll
                for (int ks = 0; ks < 2; ++ks) { u32x4 a, bq;
                    a.x = pk2(s0[8 * ks + 0], s0[8 * ks + 1]); a.y = pk2(s0[8 * ks + 2], s0[8 * ks + 3]); a.z = pk2(s0[8 * ks + 4], s0[8 * ks + 5]); a.w = pk2(s0[8 * ks + 6], s0[8 * ks + 7]);
                    bq.x = pk2(s1[8 * ks + 0], s1[8 * ks + 1]); bq.y = pk2(s1[8 * ks + 2], s1[8 * ks + 3]); bq.z = pk2(s1[8 * ks + 4], s1[8 * ks + 5]); bq.w = pk2(s1[8 * ks + 6], s1[8 * ks + 7]);
                    pb[ks] = __builtin_bit_cast(bf16x8, a); pb[2 + ks] = __builtin_bit_cast(bf16x8, bq); }
                __builtin_amdgcn_sched_barrier(0);
                VLOAD(vB, 1) PV4(o0, vA) SGB_DS_MFMA(8)
                __builtin_amdgcn_sched_barrier(0);
                VLOAD(vA, 2) PV4(o1, vB) SGB_DS_MFMA(8)
                __builtin_amdgcn_sched_barrier(0);
                VLOAD(vB, 3) PV4(o2, vA) SGB_DS_MFMA(8)
                __builtin_amdgcn_sched_barrier(0);
                PV4(o3, vB)
                __builtin_amdgcn_sched_barrier(0);
#undef KLOAD
#undef QK2
#undef VLOAD
#undef PV4
#undef SGB_DS_MFMA
            }
            if (!active) { PREFETCH_NEXT() }
#undef PREFETCH_NEXT
            if (more) { LAS unsigned char* Kn = L + (cur ^ 1) * 16384; LAS unsigned char* Vn = L + 32768 + (cur ^ 1) * 16384;
                *(LAS u32x4*)(Kn + soff0) = st0; *(LAS u32x4*)(Kn + soff1) = st1; *(LAS u32x4*)(Vn + soff0) = st2; *(LAS u32x4*)(Vn + soff1) = st3; }
            __syncthreads();
            cur ^= 1;
        }
        lrun += __shfl_xor(lrun, 32);
        const float inv = 1.0f / lrun;
        const bf16_t* gp = PROJ + (size_t)(b * SEQ + qrow) * NA + 3 * DM + h * HD + 8 * hi;
        bf16_t* op = ACT + (size_t)(b * SEQ + qrow) * DM + h * HD + 8 * hi;
#define O_STORE(OD, DB) _Pragma("unroll") for (int pr = 0; pr < 2; ++pr) { const u32x4 sw = *(const u32x4*)(gp + 32 * DB + 16 * pr); \
            const auto gx = __builtin_amdgcn_permlane32_swap(sw.x, sw.z, false, false); const auto gy = __builtin_amdgcn_permlane32_swap(sw.y, sw.w, false, false); \
              \
            const unsigned ax = pk2(OD[8 * pr + 0] * inv * bflo(gx[0]), OD[8 * pr + 1] * inv * bfhi(gx[0])), ay = pk2(OD[8 * pr + 2] * inv * bflo(gy[0]), OD[8 * pr + 3] * inv * bfhi(gy[0])); \
            const unsigned bx = pk2(OD[8 * pr + 4] * inv * bflo(gx[1]), OD[8 * pr + 5] * inv * bfhi(gx[1])), by = pk2(OD[8 * pr + 6] * inv * bflo(gy[1]), OD[8 * pr + 7] * inv * bfhi(gy[1])); \
            const auto ox = __builtin_amdgcn_permlane32_swap(ax, bx, false, false); const auto oy = __builtin_amdgcn_permlane32_swap(ay, by, false, false); \
            u32x4 ov; ov.x = ox[0]; ov.y = oy[0]; ov.z = ox[1]; ov.w = oy[1]; \
            *(u32x4*)(op + 32 * DB + 16 * pr) = ov; }
        O_STORE(o0, 0) O_STORE(o1, 1) O_STORE(o2, 2) O_STORE(o3, 3)
#undef O_STORE
    }
}

#define MFMA16(a, b, c) __builtin_amdgcn_mfma_f32_16x16x32_bf16((a), (b), (c), 0, 0, 0)
constexpr int XC_LD = 168;
template <bool LDSW>
__device__ __forceinline__ void rglru_tiles(const LAS bf16_t* XC, const bf16x8 (&WA)[5], const bf16x8 (&WX)[5], const LAS bf16x8* WL, float BA, float BX, float SP, int col, int fr, int fq, int lane,
                                            float& hc, const bf16_t* sgb, bf16_t* outb) {
    unsigned sgo = (unsigned)(4 * fq * NBP + col), outo = (unsigned)(4 * fq * RGW + col); asm volatile("" : "+v"(sgo), "+v"(outo));
    float a_[4][4], u_[4][4];
#pragma unroll
    for (int rt = 0; rt < 4; ++rt) { f32x4 aa = {0.f, 0.f, 0.f, 0.f}, ax = {0.f, 0.f, 0.f, 0.f};
#pragma unroll
        for (int ks = 0; ks < 5; ++ks) { const bf16x8 af = *(const LAS bf16x8*)(XC + (rt * 16 + fr) * XC_LD + 32 * ks + 8 * fq);
            const bf16x8 wa = LDSW ? WL[ks * 64 + lane] : WA[ks], wx = LDSW ? WL[(5 + ks) * 64 + lane] : WX[ks]; aa = MFMA16(af, wa, aa); ax = MFMA16(af, wx, ax); }
#pragma unroll
        for (int rg = 0; rg < 4; ++rg) { const int t = rt * 16 + fq * 4 + rg;
            const float r = fast_sigmoid(aa[rg] + BA), ig = fast_sigmoid(ax[rg] + BX); const float a = __builtin_amdgcn_exp2f(SP * r);
            const float xv = __uint_as_float((unsigned)XC[t * XC_LD + col] << 16);
            a_[rt][rg] = a; u_[rt][rg] = __builtin_amdgcn_sqrtf(fmaxf(1.0f - a * a, 0.f)) * ig * xv; } }
    unsigned short sg[4][4];
#pragma unroll
    for (int rt = 0; rt < 4; ++rt)
#pragma unroll
        for (int rg = 0; rg < 4; ++rg) sg[rt][rg] = sgb[sgo + (unsigned)((16 * rt + rg) * NBP)];
    float A[4], U[4];
#pragma unroll
    for (int rt = 0; rt < 4; ++rt) { float a = a_[rt][0], u = u_[rt][0];
#pragma unroll
        for (int rg = 1; rg < 4; ++rg) { u = a_[rt][rg] * u + u_[rt][rg]; a *= a_[rt][rg]; }
        A[rt] = a; U[rt] = u; }
#pragma unroll
    for (int d = 16; d <= 32; d <<= 1)
#pragma unroll
        for (int rt = 0; rt < 4; ++rt) { const float ap = __shfl_up(A[rt], d), up = __shfl_up(U[rt], d);
            if (lane >= d) { U[rt] = A[rt] * up + U[rt]; A[rt] *= ap; } }
    float Ae[4], Ue[4], At[4], Ut[4];
#pragma unroll
    for (int rt = 0; rt < 4; ++rt) { const float ap = __shfl_up(A[rt], 16), up = __shfl_up(U[rt], 16); Ae[rt] = fq ? ap : 1.0f; Ue[rt] = fq ? up : 0.0f;
        At[rt] = __shfl(A[rt], 48 + fr); Ut[rt] = __shfl(U[rt], 48 + fr); }
    float h = hc;
#pragma unroll
    for (int rt = 0; rt < 4; ++rt) { float hh = Ae[rt] * h + Ue[rt];
#pragma unroll
        for (int rg = 0; rg < 4; ++rg) { hh = a_[rt][rg] * hh + u_[rt][rg];
            const float o = hh * __uint_as_float((unsigned)sg[rt][rg] << 16);
            outb[outo + (unsigned)((16 * rt + rg) * RGW)] = (bf16_t)(pk2(o, 0.f) & 0xffffu); }
        h = At[rt] * h + Ut[rt]; }
    hc = h;
}
struct RgSplit { float a[4], u[4], Ae, Ue; unsigned short sg[4]; };
__device__ __forceinline__ void rglru_split1(const LAS bf16_t* XC, const LAS bf16x8* WL, float BA, float BX, float SP, int col, int rt, int fr, int fq, int lane, LAS f32x2* TOT, const bf16_t* sgb, RgSplit& st) {
    unsigned sgo = (unsigned)((16 * rt + 4 * fq) * NBP + col); asm volatile("" : "+v"(sgo));
#pragma unroll
    for (int rg = 0; rg < 4; ++rg) st.sg[rg] = sgb[sgo + (unsigned)(rg * NBP)];
    f32x4 aa = {0.f, 0.f, 0.f, 0.f}, ax = {0.f, 0.f, 0.f, 0.f};
#pragma unroll
    for (int ks = 0; ks < 5; ++ks) { const bf16x8 af = *(const LAS bf16x8*)(XC + (rt * 16 + fr) * XC_LD + 32 * ks + 8 * fq); aa = MFMA16(af, WL[ks * 64 + lane], aa); ax = MFMA16(af, WL[(5 + ks) * 64 + lane], ax); }
#pragma unroll
    for (int rg = 0; rg < 4; ++rg) { const int t = rt * 16 + fq * 4 + rg;
        const float r = fast_sigmoid(aa[rg] + BA), ig = fast_sigmoid(ax[rg] + BX); const float a = __builtin_amdgcn_exp2f(SP * r);
        const float xv = __uint_as_float((unsigned)XC[t * XC_LD + col] << 16);
        st.a[rg] = a; st.u[rg] = __builtin_amdgcn_sqrtf(fmaxf(1.0f - a * a, 0.f)) * ig * xv; }
    float A = st.a[0], U = st.u[0];
#pragma unroll
    for (int rg = 1; rg < 4; ++rg) { U = st.a[rg] * U + st.u[rg]; A *= st.a[rg]; }
#pragma unroll
    for (int d = 16; d <= 32; d <<= 1) { const float ap = __shfl_up(A, d), up = __shfl_up(U, d); if (lane >= d) { U = A * up + U; A *= ap; } }
    { const float ap = __shfl_up(A, 16), up = __shfl_up(U, 16); st.Ae = fq ? ap : 1.0f; st.Ue = fq ? up : 0.0f; }
    if (fq == 3) TOT[rt * 16 + fr] = (f32x2){A, U};
}
__device__ __forceinline__ void rglru_split2(const LAS f32x2* TOT, int col, int rtA, int fr, int fq, float& hc, bf16_t* outb, const RgSplit& sa, const RgSplit& sb) {
    float h = hc, hinA = hc, hinB = hc;
#pragma unroll
    for (int r2 = 0; r2 < 8; ++r2) { const f32x2 t = TOT[r2 * 16 + fr]; if (r2 == rtA) hinA = h; if (r2 == rtA + 4) hinB = h; h = t.x * h + t.y; }
    hc = h;
#pragma unroll
    for (int half = 0; half < 2; ++half) { const RgSplit& st = half ? sb : sa; const int rt = rtA + 4 * half;
        unsigned outo = (unsigned)((16 * rt + 4 * fq) * RGW + col); asm volatile("" : "+v"(outo));
        float hh = st.Ae * (half ? hinB : hinA) + st.Ue;
#pragma unroll
        for (int rg = 0; rg < 4; ++rg) { hh = st.a[rg] * hh + st.u[rg];
            const float o = hh * __uint_as_float((unsigned)st.sg[rg] << 16);
            outb[outo + (unsigned)(rg * RGW)] = (bf16_t)(pk2(o, 0.f) & 0xffffu); } }
}
__device__ __forceinline__ void rglru_phase(LAS unsigned char* L, const bf16_t* PROJ, bf16_t* ACT, const float* conv_w, const float* conv_b, const bf16x8* GW, const float* gab,
                                            const float* gxb, const float* lam, int G, int blk, const int tid) {
    const int lane = tid & 63, w = __builtin_amdgcn_readfirstlane(tid >> 6), fr = lane & 15, fq = lane >> 4;
    LAS bf16_t* XC = (LAS bf16_t*)L;
    LAS bf16_t* XR = (LAS bf16_t*)(L + 43008);
    LAS float* CW = (LAS float*)(L + 43008 + 44032);
    for (int unit = blk; unit < NBATCH * 16; unit += G) {
        int b = unit >> 4, nb = unit & 15;
        if (G == 256) { const int x = blk & 7, j = blk >> 3; b = 2 * x + (j >> 4); nb = j & 15; }
        const int ch0 = nb * 160;
        __syncthreads();
        for (int i = tid; i < 800; i += 512) { const int j = i / 160, ch = i - j * 160; CW[i] = j < 4 ? conv_w[j * RGW + ch0 + ch] : conv_b[ch0 + ch]; }
        bf16x8 wa0[5], wx0[5];
        LAS bf16x8* WL = (LAS bf16x8*)(L + 43008 + 44032 + 3200) + (w >> 2) * 640;
        LAS f32x2* TOT = (LAS f32x2*)(L + 43008 + 44032 + 3200 + 20480) + (w >> 2) * 128;
        const int w1 = 8 + (w >> 2), rt1 = w & 3;
        const int col0 = w * 16 + fr, col1 = w1 * 16 + fr;
        { const bf16x8* ga0 = GW + ((size_t)((0 * 16 + nb) * 10 + w) * 5) * 64 + lane; const bf16x8* gx0 = GW + ((size_t)((1 * 16 + nb) * 10 + w) * 5) * 64 + lane;
          const bf16x8* ga1 = GW + ((size_t)((0 * 16 + nb) * 10 + w1) * 5) * 64 + lane; const bf16x8* gx1 = GW + ((size_t)((1 * 16 + nb) * 10 + w1) * 5) * 64 + lane;
#pragma unroll
          for (int ks = 0; ks < 5; ++ks) { wa0[ks] = ga0[ks * 64]; wx0[ks] = gx0[ks * 64]; if ((w & 3) == 0) { WL[ks * 64 + lane] = ga1[ks * 64]; WL[(5 + ks) * 64 + lane] = gx1[ks * 64]; } } }
        const float ba0 = gab[ch0 + col0], bx0 = gxb[ch0 + col0], ba1 = gab[ch0 + col1], bx1 = gxb[ch0 + col1];
        const float l0 = lam[ch0 + col0], l1 = lam[ch0 + col1];
        const float sp0 = -8.0f * LOG2E * (fmaxf(-l0, 0.f) + log1pexp_neg_abs(l0)), sp1 = -8.0f * LOG2E * (fmaxf(-l1, 0.f) + log1pexp_neg_abs(l1));
        float hc0 = 0.f, hc1 = 0.f;
        u32x2 xs[11];
        const bf16_t* xbase = PROJ + (size_t)b * SEQ * NBP + ch0;
#define XR_LOAD(T0) { _Pragma("unroll") for (int k = 0; k < 11; ++k) { const int i = tidc + 512 * k, r = i / 40, c4 = (i - r * 40) * 4, tt = (T0) - 3 + r; \
            xs[k] = (u32x2){0u, 0u}; if (i < 5240 && tt >= 0) xs[k] = *(const u32x2*)(xbase + (size_t)tt * NBP + c4); } }
#define XR_STORE() { _Pragma("unroll") for (int k = 0; k < 11; ++k) { const int i = tidc + 512 * k, r = i / 40, c4 = (i - r * 40) * 4; if (i < 5240) *(LAS u32x2*)(XR + r * XC_LD + c4) = xs[k]; } }
        { int tidc = tid; asm volatile("" : "+v"(tidc)); XR_LOAD(0) XR_STORE() }
        __syncthreads();
        for (int chunk = 0; chunk < SEQ / 128; ++chunk) {
            const int t0 = chunk * 128;
            int tidc = tid; asm volatile("" : "+v"(tidc));
#pragma unroll 5
            for (int it = 0; it < 10; ++it) { const int i = tidc + 512 * it, t = i / 40, c4 = (i - t * 40) * 4;
                f32x4 acc = *(const LAS f32x4*)(CW + 640 + c4);
#pragma unroll
                for (int j = 0; j < 4; ++j) { const u32x2 xv = *(const LAS u32x2*)(XR + (t + j) * XC_LD + c4); const f32x4 cw4 = *(const LAS f32x4*)(CW + j * 160 + c4);
                    acc.x += bflo(xv.x) * cw4.x; acc.y += bfhi(xv.x) * cw4.y; acc.z += bflo(xv.y) * cw4.z; acc.w += bfhi(xv.y) * cw4.w; }
                u32x2 o; o.x = pk2(acc.x, acc.y); o.y = pk2(acc.z, acc.w); *(LAS u32x2*)(XC + t * XC_LD + c4) = o; }
            if (chunk + 1 < SEQ / 128) XR_LOAD(t0 + 128)
            __syncthreads();
            if (chunk + 1 < SEQ / 128) XR_STORE()
            const size_t trow = (size_t)(b * SEQ + t0);
            RgSplit spa, spb;
            rglru_tiles<false>(XC, wa0, wx0, WL, ba0, bx0, sp0, col0, fr, fq, lane, hc0, PROJ + trow * NBP + RGW + ch0, ACT + trow * RGW + ch0);
            rglru_tiles<false>(XC + 64 * XC_LD, wa0, wx0, WL, ba0, bx0, sp0, col0, fr, fq, lane, hc0, PROJ + (trow + 64) * NBP + RGW + ch0, ACT + (trow + 64) * RGW + ch0);
            rglru_split1(XC, WL, ba1, bx1, sp1, col1, rt1, fr, fq, lane, TOT, PROJ + trow * NBP + RGW + ch0, spa);
            rglru_split1(XC, WL, ba1, bx1, sp1, col1, rt1 + 4, fr, fq, lane, TOT, PROJ + trow * NBP + RGW + ch0, spb);
            __syncthreads();
            rglru_split2(TOT, col1, rt1, fr, fq, hc1, ACT + trow * RGW + ch0, spa, spb);
        }
#undef XR_LOAD
#undef XR_STORE
    }
}

#define XB_TMO      128
#define XB_XCNT(j)  (256  + 64 * (j))
#define XB_XSUB(j)  (1280 + 64 * (j))
#define XB_XGEN(j)  (2304 + 64 * (j))
#define XB_TOP      3328
#define XB_TOPGEN   3392
#define XCD_BAR_WORDS 3456
#define XB_SPIN_CAP (1u << 18)

__device__ __forceinline__ unsigned xb_ld(unsigned* p)              { return __hip_atomic_load(p, __ATOMIC_RELAXED, __HIP_MEMORY_SCOPE_AGENT); }
__device__ __forceinline__ unsigned xb_add(unsigned* p, unsigned v) { return __hip_atomic_fetch_add(p, v, __ATOMIC_RELAXED, __HIP_MEMORY_SCOPE_AGENT); }
__device__ __forceinline__ unsigned xb_xcc_id() { return (unsigned)__builtin_amdgcn_s_getreg((3 << 11) | 20) & 0xFu; }
#define XB_SPIN(cond, bar) do { unsigned _sp = 0; while (cond) { __builtin_amdgcn_s_sleep(1); \
    if ((++_sp & 255u) == 0u) { if (xb_ld(&(bar)[XB_TMO])) break; if (_sp > XB_SPIN_CAP) { atomicAdd(&(bar)[XB_TMO], 1u); break; } } } } while (0)

struct XcdBarrier {
    unsigned* bar; unsigned x;
    volatile LAS unsigned* st;
};

__device__ __forceinline__ XcdBarrier xcd_barrier_post(unsigned* bar, volatile LAS unsigned* st) {
    XcdBarrier b; b.bar = bar; b.x = xb_xcc_id(); b.st = st;
    if (threadIdx.x == 0) (void)xb_add(&bar[XB_XCNT(b.x)], 1u);
    return b;
}
__device__ __forceinline__ void xcd_barrier_complete(unsigned* bar, unsigned x, unsigned& nloc, unsigned& nx) {
    const unsigned G = gridDim.x * gridDim.y * gridDim.z;
    unsigned sum, cnt, mine, sp = 0u;
    for (;;) {
        sum = 0u; cnt = 0u; mine = 0u;
#pragma unroll
        for (unsigned j = 0; j < 16; ++j) { const unsigned c = xb_ld(&bar[XB_XCNT(j)]); sum += c; cnt += (c > 0u) ? 1u : 0u; mine = (j == x) ? c : mine; }
        if (sum == G) break;
        __builtin_amdgcn_s_sleep(1);
        if ((++sp & 255u) == 0u) { if (xb_ld(&bar[XB_TMO])) break; if (sp > XB_SPIN_CAP) { atomicAdd(&bar[XB_TMO], 1u); break; } }
    }
    nloc = mine > 0u ? mine : 1u; nx = cnt > 0u ? cnt : 1u;
}

__device__ __forceinline__ void xcd_barrier(const XcdBarrier& b) {
    asm volatile("s_waitcnt vmcnt(0)" ::: "memory");
    __syncthreads();
    if (threadIdx.x == 0) {
        unsigned* bar = b.bar;
        __builtin_amdgcn_s_waitcnt(0);
        unsigned nloc = b.st[0], nx = b.st[1];
        if (nloc == 0u) { xcd_barrier_complete(bar, b.x, nloc, nx); b.st[0] = nloc; b.st[1] = nx; }
        const unsigned old = xb_add(&bar[XB_XSUB(b.x)], 1u);
        const unsigned gen = old / nloc;
        if (old + 1u == (gen + 1u) * nloc) {
            __builtin_amdgcn_fence(__ATOMIC_RELEASE, "agent");
            asm volatile("s_waitcnt vmcnt(0)" ::: "memory");
            const unsigned og = xb_add(&bar[XB_TOP], 1u);
            const unsigned tg = og / nx;
            if (og + 1u == (tg + 1u) * nx) xb_add(&bar[XB_TOPGEN], 1u);
            else XB_SPIN(xb_ld(&bar[XB_TOPGEN]) == tg, bar);
            __builtin_amdgcn_fence(__ATOMIC_ACQUIRE, "agent");
            xb_add(&bar[XB_XGEN(b.x)], 1u);
            asm volatile("s_waitcnt vmcnt(0)" ::: "memory");
        } else {
            XB_SPIN(xb_ld(&bar[XB_XGEN(b.x)]) == gen, bar);
            __builtin_amdgcn_fence(__ATOMIC_ACQUIRE, "agent");
            asm volatile("s_waitcnt vmcnt(0)" ::: "memory");
        }
    }
    __syncthreads();
}

#ifndef MK_LAUNCHES
#define MK_LAUNCHES 1
#endif
#ifndef FUSE_ROW
#define FUSE_ROW 1
#endif
#ifndef ROW_NR
#define ROW_NR 2
#endif
#ifndef GEMM_SP2
#define GEMM_SP2 true
#endif
#ifndef GEMM_ALIGN
#define GEMM_ALIGN true
#endif
#ifndef STAGGER_TICKS
#define STAGGER_TICKS 0
#endif
#ifndef PROBE_REPEAT_MASK
#define PROBE_REPEAT_MASK 0x0
#endif
__global__ void __launch_bounds__(512, 2) hybrid_trunk_mega(Params p) {
    extern __shared__ __attribute__((aligned(16))) unsigned char lds_raw[];
    LAS unsigned char* L = (LAS unsigned char*)lds_raw;
    cg::grid_group grid = cg::this_grid();
    if (threadIdx.x < 4) ((LAS unsigned*)(L + LDS_BYTES - 16))[threadIdx.x] = 0u;
    __syncthreads();
    XcdBarrier xbar = xcd_barrier_post((unsigned*)(p.ws + WS_BAR), (volatile LAS unsigned*)(L + LDS_BYTES - 16));
    const int G = gridDim.x, blk = blockIdx.x;
    unsigned char* ws = p.ws;
    bf16_t* ACT = (bf16_t*)(ws + WS_ACT); bf16_t* XB = (bf16_t*)(ws + WS_XB); float* XS = (float*)(ws + WS_XS); float* YS = (float*)(ws + WS_YS); unsigned* CNT = (unsigned*)(ws + WS_CNT); bf16_t* PROJ = (bf16_t*)(ws + WS_PROJ); bf16_t* YB = (bf16_t*)(ws + WS_PROJ);
    float* LOGF = (float*)(ws + WS_LOGF); float* CUMB = (float*)(ws + WS_CUMB);
    const bool fused = FUSE_ROW != 0;
    for (int ph = p.ph_lo; ph < p.ph_hi; ++ph) {
      if (fused && ph > 0 && ((ph - 1) & 3) == 3 && ((ph - 1) >> 2) != 1) continue;
      {
        int tid = threadIdx.x; asm volatile("" : "+v"(tid));
        const int lane = tid & 63, wave = __builtin_amdgcn_readfirstlane(tid >> 6);
        if (ph == 0) {
#ifndef SKIP_PRO
            prologue_phase(p, L, G, blk, wave, lane);
#endif
        }
        else {
            const int layer = (ph - 1) >> 2, sub = (ph - 1) & 3, mix = layer % 3, j = layer / 3;
            if (sub == 0) {
                const bf16_t* Wt = mix == 0 ? (const bf16_t*)(ws + WS_WA_IN + (size_t)j * 32 * MiB) : mix == 1 ? (const bf16_t*)(ws + WS_WB_IN) : (const bf16_t*)(ws + WS_WC_IN);
                const int N = mix == 1 ? NBP : NA;
                if (mix == 2) cumsum_phase(LOGF, CUMB, (LAS float*)L, G, blk, tid);
                pg8::Gemm g{XB, Wt, MTOK, N, DM}; pg8::StaticOrder S; S.init(MTOK, N, G, blk);
                LAS float* RS = (LAS float*)(L + 131072);
                if (G == 256) { const int pmA = 16 * (blk & 7) + ((blk >> 3) & 7);
                    RS[tid] = 1.0f / sqrtf(pg8::slot_sum8(XS + ((size_t)layer * MTOK + (pmA + 8 * (tid >> 8)) * 256 + (tid & 255)) * 8) * (1.0f / DM) + RMS_EPS); __syncthreads(); }
                pg8::EpiProj E{PROJ, N, mix == 1 ? 0 : DM, QSCALE, mix == 1 ? RGW : 3 * DM, XS + (size_t)layer * MTOK * 8, G == 256 ? (const LAS float*)RS : (const LAS float*)nullptr};
#if STAGGER_TICKS > 0
                { const unsigned long long t_end = __builtin_amdgcn_s_memrealtime() + (unsigned long long)(((blk >> 3) & 15) * STAGGER_TICKS);
                  while (__builtin_amdgcn_s_memrealtime() < t_end) __builtin_amdgcn_s_sleep(8); }
#endif
#ifndef SKIP_GEMM1
                pg8::gemm_phase2<pg8::EpiProj, pg8::StaticOrder, GEMM_ALIGN, GEMM_SP2>(L, g, S, E, tid);
#endif
            } else if (sub == 1) {
#ifndef SKIP_ATTN0
                if (mix == 0) attn_phase<0>(L, PROJ, ACT, p.in[4] + (size_t)j * NHEAD * NREL, G, blk, tid);
#endif
#ifndef SKIP_RGLRU
                if (mix == 1) rglru_phase(L, PROJ, ACT, p.in[7], p.in[8], (const bf16x8*)(ws + WS_GW), p.in[10], p.in[12], p.in[13], G, blk, tid);
#endif
#ifndef SKIP_ATTN1
                if (mix == 2) attn_phase<1>(L, PROJ, ACT, CUMB, G, blk, tid);
#endif
            } else if (sub == 2) {
                const bf16_t* Wt = mix == 0 ? (const bf16_t*)(ws + WS_WA_OUT + (size_t)j * 8 * MiB) : mix == 1 ? (const bf16_t*)(ws + WS_WB_OUT) : (const bf16_t*)(ws + WS_WC_OUT);
                const int K = mix == 1 ? RGW : DM;
                pg8::Gemm g{ACT, Wt, MTOK, DM, K}; pg8::StaticOrder S; S.init(MTOK, DM, G, blk);
#ifndef SKIP_GEMM2
                if (fused) {
                    pg8::PanelOrder PO{blk};
                    static_assert(pg8::FUSE_XB == WS_XB && pg8::FUSE_XS == WS_XS && pg8::FUSE_YS == WS_YS && pg8::FUSE_CNT == WS_CNT, "fused-epilogue buffer offsets");
                    pg8::EpiFuse EF{ws, layer == 3 ? p.out : nullptr, p.in[2] + (size_t)layer * DM, layer, (LAS float*)(L + 133120)};
                    pg8::gemm_phase2<pg8::EpiFuse, pg8::PanelOrder, true, GEMM_SP2>(L, g, PO, EF, tid);
                }
#if !FUSE_ROW
                else {
                    pg8::EpiProj E{YB, DM, 0, 1.0f, 1 << 30, nullptr, nullptr};
                    pg8::gemm_phase2<pg8::EpiProj, pg8::StaticOrder, GEMM_ALIGN, GEMM_SP2>(L, g, S, E, tid);
                }
#endif
#endif
            } else {
                const float* gpre = layer < 3 ? p.in[1] + (size_t)(layer + 1) * DM : nullptr;
                const float* wf = (layer + 1) % 3 == 2 && layer < 3 ? p.in[15] + 4 * DM : nullptr;
#ifndef SKIP_ROW
                if (fused) { if (wf) flogit_phase(XB, XS + (size_t)(layer + 1) * MTOK * 8, gpre, wf, p.in[16], LOGF, blk * 8 + wave, G * 8, lane, (LAS float*)L, tid); }
#if !FUSE_ROW
                else if (layer == 0) row_phase<ROW_NR, true>(YB, p.in[0], XB, nullptr, p.in[2], XS + (size_t)MTOK * 8, gpre, nullptr, p.in[16], LOGF, blk * 8 + wave, G * 8, lane, (LAS float*)L, tid);
                else row_phase<ROW_NR, false>(YB, nullptr, XB, layer == 3 ? p.out : nullptr, p.in[2] + (size_t)layer * DM, XS + (size_t)(layer + 1) * MTOK * 8, gpre, wf, p.in[16], LOGF, blk * 8 + wave, G * 8, lane, (LAS float*)L, tid);
#endif
#endif
            }
        }
      }
        if (ph + 1 < p.ph_hi && !(fused && ph == NPHASE - 2)) { if (p.ph_lo < 0) grid.sync(); else xcd_barrier(xbar); }
    }
}

extern "C" void kernel_launch(void* const* d_in, const int* in_sizes, int n_in, void* d_out, int out_size, void* d_ws, size_t ws_size, hipStream_t stream) {
    static int grid = 0;
    if (grid == 0) {
        if (n_in != 18 || in_sizes[0] != MTOK * DM || out_size != MTOK * DM || ws_size < WS_END) {
            fprintf(stderr, "kernel_launch: unexpected shapes (n_in %d, in0 %d, out %d, ws %zu; need ws >= %zu)\n", n_in, n_in > 0 ? in_sizes[0] : -1, out_size, ws_size, (size_t)WS_END); grid = -1; return; }
        int dev = 0, cus = 0, per_cu = 0;
        (void)hipGetDevice(&dev); (void)hipDeviceGetAttribute(&cus, hipDeviceAttributeMultiprocessorCount, dev);
        if (hipFuncSetAttribute((const void*)hybrid_trunk_mega, hipFuncAttributeMaxDynamicSharedMemorySize, LDS_BYTES) != hipSuccess) { fprintf(stderr, "kernel_launch: hipFuncSetAttribute failed\n"); grid = -1; return; }
        if (hipOccupancyMaxActiveBlocksPerMultiprocessor(&per_cu, (const void*)hybrid_trunk_mega, 512, LDS_BYTES) != hipSuccess || per_cu < 1) { fprintf(stderr, "kernel_launch: occupancy query gave %d\n", per_cu); per_cu = 1; }
        (void)hipGetLastError();
        grid = cus * per_cu;
        if (FUSE_ROW && grid != 256) { fprintf(stderr, "kernel_launch: this build needs a 256-workgroup grid (got %d)\n", grid); grid = -1; return; }
    }
    if (grid < 0) return;
    if (hipMemsetAsync((char*)d_ws + WS_CTL, 0, CTL_BYTES, stream) != hipSuccess) { fprintf(stderr, "kernel_launch: memset of the barrier words failed\n"); return; }
    Params p{};
    for (int i = 0; i < 18; ++i) p.in[i] = (const float*)d_in[i];
    p.out = (float*)d_out; p.ws = (unsigned char*)d_ws;
#if MK_LAUNCHES == 1
    p.ph_lo = 0; p.ph_hi = NPHASE;
    void* args[] = {&p};
    const hipError_t e = hipLaunchCooperativeKernel((const void*)hybrid_trunk_mega, dim3(grid), dim3(512), args, LDS_BYTES, stream);
    if (e != hipSuccess) fprintf(stderr, "kernel_launch: cooperative launch failed: %s (grid %d)\n", hipGetErrorString(e), grid);
#else
    for (int ph = 0; ph < NPHASE; ++ph) { p.ph_lo = ph; p.ph_hi = ph + 1; hipLaunchKernelGGL(hybrid_trunk_mega, dim3(grid), dim3(512), LDS_BYTES, stream, p); }
#endif
}
```

```cpp
#include <hip/hip_runtime.h>
#include <hip/hip_cooperative_groups.h>
#include <cstdio>
#include <cstdint>
namespace cg = cooperative_groups;
namespace pg8 {
#define PG8_LAS __attribute__((address_space(3)))
typedef unsigned short bf16_t;
typedef short bf16x8 __attribute__((ext_vector_type(8)));
typedef float f32x4 __attribute__((ext_vector_type(4)));
typedef unsigned u32x4 __attribute__((ext_vector_type(4)));
constexpr int BM = 256, BK = 64, HALF = 128, HTB = HALF * BK * 2  , STAGE_BYTES = 8 * HTB, NXCD = 8, WGM = 8;

__host__ __device__ __forceinline__ int lds_byte(int r, int c) { const int st = (r >> 4) * 2 + (c >> 5), rr = r & 15, cc = c & 31, ob = rr * 64 + cc * 2; return st * 1024 + (ob ^ (((ob >> 9) & 1) << 5)); }
__host__ __device__ __forceinline__ void stage_rc(int b, int& R, int& C) { const int st = b / 1024, sb = b % 1024, swz = sb ^ (((sb >> 9) & 1) << 5); R = (st >> 1) * 16 + swz / 64; C = (st & 1) * 32 + (swz % 64) / 2; }
__host__ __device__ __forceinline__ int perm32(int rho) { const int n = rho >> 4, i = rho & 15; return 8 * (i >> 2) + 4 * n + (i & 3); }

struct Unit { int pm, pn; };
struct Gemm { const bf16_t* A; const bf16_t* Bt; int M, N, K; };

struct StaticOrder {
    int nM, nN, nwg, G, c;
    __host__ __device__ void init(int M, int N, int G_, int c_) { nM = M / BM; nN = N / BM; nwg = nM * nN; G = G_; c = c_; }
    __host__ __device__ bool next(int i, Unit& u) const {
        const long L = (long)i * G + c; if (L >= nwg) return false;
        int wgid = (int)L; { const int q = nwg / NXCD, r = nwg % NXCD, xcd = wgid % NXCD, off = wgid / NXCD; wgid = (xcd < r ? xcd * (q + 1) : r * (q + 1) + (xcd - r) * q) + off; }
        const int nig = WGM * nN, gid = wgid / nig, fm = gid * WGM, gsz = (nM - fm) < WGM ? (nM - fm) : WGM;
        u.pm = fm + ((wgid % nig) % gsz); u.pn = (wgid % nig) / gsz; return true;
    }
    __device__ __forceinline__ void a_ready(const Unit&) const {}
    __device__ __forceinline__ void done(const Unit&) const {}
};
__device__ __forceinline__ unsigned cvt_pk_bf16(float lo, float hi) { unsigned r; asm volatile("v_cvt_pk_bf16_f32 %0, %1, %2" : "=v"(r) : "v"(lo), "v"(hi)); return r; }
typedef float f32x2 __attribute__((ext_vector_type(2)));
struct EpiF32 {
    static constexpr bool PERM = false, AFTER_DRAIN = false;
    float* C; int ldc; const float* bias;
    __device__ __forceinline__ void operator()(const f32x4 (&acc)[2][2][4][2], const Unit& u, int wr, int wc, int fr, int fq) const {
        const int row0 = u.pm * BM + wr * 64 + fr, col0 = u.pn * BM + wc * 32 + 4 * fq;
        f32x4 bv[2][2];
#pragma unroll
        for (int bj = 0; bj < 2; ++bj)
#pragma unroll
            for (int n = 0; n < 2; ++n) bv[bj][n] = bias ? *(const f32x4*)(bias + col0 + bj * HALF + n * 16) : (f32x4){0.f, 0.f, 0.f, 0.f};
#pragma unroll
        for (int ai = 0; ai < 2; ++ai)
#pragma unroll
            for (int m = 0; m < 4; ++m) { float* rowp = C + (size_t)(row0 + ai * HALF + m * 16) * ldc + col0;
#pragma unroll
                for (int bj = 0; bj < 2; ++bj)
#pragma unroll
                    for (int n = 0; n < 2; ++n) *(f32x4*)(rowp + bj * HALF + n * 16) = acc[ai][bj][m][n] + bv[bj][n]; }
    }
};
template <class Epi, class Sched>
__device__ __forceinline__ void gemm_phase(PG8_LAS unsigned char* lds, const Gemm g, const Sched& S, const Epi& E, const int tid_in) {
    const int tid = tid_in, wid = __builtin_amdgcn_readfirstlane(tid >> 6), lane = tid & 63, wr = wid >> 2, wc = wid & 3, fr = lane & 15, fq = lane >> 4;
    const int K = g.K, nt = K / BK;
    unsigned voffA[2], voffB[2];
#pragma unroll
    for (int i = 0; i < 2; ++i) { int R, C; stage_rc(tid * 16 + i * 8192, R, C); const int Rb = Epi::PERM ? ((R & ~31) + perm32(R & 31)) : R;
        voffA[i] = (unsigned)(R * K + C) * 2u; voffB[i] = (unsigned)(Rb * K + C) * 2u; }
    const size_t kstep = (size_t)(BK * 2);
    const size_t hstep = (size_t)HALF * K * 2;
    const size_t tstep = 2 * hstep;
    const unsigned ldsw = (unsigned)wid * 1024u;
    const int aoff = lds_byte(wr * 64 + fr, fq * 8), boff = lds_byte(wc * 32 + fr, fq * 8);
#define PG8_SA(b, h) (((b) * 2 + (h)) * HTB)
#define PG8_SB(b, h) ((4 + (b) * 2 + (h)) * HTB)
#define PG8_STAGE(bufoff, gbase, voff) do { _Pragma("unroll") for (int _i = 0; _i < 2; ++_i) \
        __builtin_amdgcn_global_load_lds((const unsigned*)((const char*)(gbase) + (voff)[_i]), (PG8_LAS unsigned*)(lds + (bufoff) + ldsw + _i * 8192), 16, 0, 0); } while (0)
#define PG8_LDA(dst, b, h) do { _Pragma("unroll") for (int m = 0; m < 4; ++m) _Pragma("unroll") for (int k = 0; k < 2; ++k) dst[m][k] = *(const PG8_LAS bf16x8*)(lds + PG8_SA(b, h) + aoff + m * 2048 + k * 1024); } while (0)
#define PG8_LDB(dst, b, h) do { _Pragma("unroll") for (int n = 0; n < 2; ++n) _Pragma("unroll") for (int k = 0; k < 2; ++k) dst[n][k] = *(const PG8_LAS bf16x8*)(lds + PG8_SB(b, h) + boff + n * 2048 + k * 1024); } while (0)
#define PG8_MMA(ai, bj, At, Bt) do { __builtin_amdgcn_s_setprio(1); _Pragma("unroll") for (int m = 0; m < 4; ++m) _Pragma("unroll") for (int n = 0; n < 2; ++n) _Pragma("unroll") for (int k = 0; k < 2; ++k) \
        acc[ai][bj][m][n] = __builtin_amdgcn_mfma_f32_16x16x32_bf16(Bt[n][k], At[m][k], acc[ai][bj][m][n], 0, 0, 0); __builtin_amdgcn_s_setprio(0); } while (0)
#define PG8_WAIT_V(n) asm volatile("s_waitcnt vmcnt(" #n ")" ::: "memory")
#define PG8_WAIT_L(n) asm volatile("s_waitcnt lgkmcnt(" #n ")" ::: "memory")
#define PG8_BAR __builtin_amdgcn_s_barrier()
#define PG8_SCHED __builtin_amdgcn_sched_barrier(0)
    Unit cur, nxt; int ui = 0;
    if (!S.next(0, cur)) return;
    f32x4 acc[2][2][4][2];
#pragma unroll
    for (int a = 0; a < 2; ++a)
#pragma unroll
        for (int b = 0; b < 2; ++b)
#pragma unroll
            for (int m = 0; m < 4; ++m)
#pragma unroll
                for (int n = 0; n < 2; ++n) acc[a][b][m][n] = (f32x4){0.f, 0.f, 0.f, 0.f};
    bf16x8 At[4][2], B0[2][2], B1[2][2];
    const char* cA = (const char*)g.A + (size_t)cur.pm * tstep; const char* cB = (const char*)g.Bt + (size_t)cur.pn * tstep;
    S.a_ready(cur);
    PG8_STAGE(PG8_SB(0, 0), cB, voffB); PG8_STAGE(PG8_SA(0, 0), cA, voffA); PG8_STAGE(PG8_SB(0, 1), cB + hstep, voffB); PG8_STAGE(PG8_SA(0, 1), cA + hstep, voffA);
    if (wr == 1) PG8_BAR;
    PG8_WAIT_V(4); PG8_BAR;
    PG8_STAGE(PG8_SB(1, 0), cB + kstep, voffB); PG8_STAGE(PG8_SA(1, 0), cA + kstep, voffA); PG8_STAGE(PG8_SB(1, 1), cB + hstep + kstep, voffB);
    PG8_WAIT_V(6); PG8_BAR;
    for (;;) {
        const bool has_next = S.next(ui + 1, nxt);
        const char* nA = has_next ? (const char*)g.A + (size_t)nxt.pm * tstep : cA; const char* nB = has_next ? (const char*)g.Bt + (size_t)nxt.pn * tstep : cB;
        for (int t = 0; t < nt; t += 2) {
            const bool last = (t == nt - 2);
            const char* a1 = cA + (size_t)(t + 1) * kstep;
            const char* a2 = last ? nA : cA + (size_t)(t + 2) * kstep; const char* b2 = last ? nB : cB + (size_t)(t + 2) * kstep;
            const char* a3 = a2 + kstep; const char* b3 = b2 + kstep;
            if (last && has_next) S.a_ready(nxt);
            PG8_LDB(B0, 0, 0); PG8_SCHED; PG8_LDA(At, 0, 0); PG8_STAGE(PG8_SA(1, 1), a1 + hstep, voffA);
            PG8_WAIT_L(8); PG8_BAR; PG8_WAIT_L(0); PG8_MMA(0, 0, At, B0); PG8_BAR; PG8_SCHED;
            PG8_LDB(B1, 0, 1); PG8_STAGE(PG8_SB(0, 0), b2, voffB);
            PG8_BAR; PG8_WAIT_L(0); PG8_MMA(0, 1, At, B1); PG8_BAR;
            PG8_LDA(At, 0, 1); PG8_STAGE(PG8_SA(0, 0), a2, voffA);
            PG8_BAR; PG8_WAIT_L(0); PG8_MMA(1, 0, At, B0); PG8_BAR; PG8_SCHED;
            PG8_STAGE(PG8_SB(0, 1), b2 + hstep, voffB);
            PG8_WAIT_V(6); PG8_BAR; PG8_MMA(1, 1, At, B1); PG8_BAR;
            PG8_LDB(B0, 1, 0); PG8_SCHED; PG8_LDA(At, 1, 0); PG8_STAGE(PG8_SA(0, 1), a2 + hstep, voffA);
            PG8_WAIT_L(8); PG8_BAR; PG8_WAIT_L(0); PG8_MMA(0, 0, At, B0); PG8_BAR; PG8_SCHED;
            PG8_LDB(B1, 1, 1); PG8_STAGE(PG8_SB(1, 0), b3, voffB);
            PG8_BAR; PG8_WAIT_L(0); PG8_MMA(0, 1, At, B1); PG8_BAR;
            PG8_LDA(At, 1, 1); PG8_STAGE(PG8_SA(1, 0), a3, voffA);
            PG8_BAR; PG8_WAIT_L(0); PG8_MMA(1, 0, At, B0); PG8_BAR; PG8_SCHED;
            PG8_STAGE(PG8_SB(1, 1), b3 + hstep, voffB);
            PG8_WAIT_V(6); PG8_BAR; PG8_MMA(1, 1, At, B1); PG8_BAR;
        }
        if constexpr (!Epi::AFTER_DRAIN) { E(acc, cur, wr, wc, fr, fq); S.done(cur); }
        if (!has_next) break;
#pragma unroll
        for (int a = 0; a < 2; ++a)
#pragma unroll
            for (int b = 0; b < 2; ++b)
#pragma unroll
                for (int m = 0; m < 4; ++m)
#pragma unroll
                    for (int n = 0; n < 2; ++n) acc[a][b][m][n] = (f32x4){0.f, 0.f, 0.f, 0.f};
        cur = nxt; cA = nA; cB = nB; ++ui;
    }
    PG8_WAIT_V(0);
    if (wr == 0) PG8_BAR;
    PG8_BAR;
    if constexpr (Epi::AFTER_DRAIN) { E.fused(acc, cur, wr, wc, fr, fq, lds, wid, lane); S.done(cur); }
#undef PG8_SA
#undef PG8_SB
#undef PG8_STAGE
#undef PG8_LDA
#undef PG8_LDB
#undef PG8_MMA
#undef PG8_WAIT_V
#undef PG8_WAIT_L
#undef PG8_BAR
#undef PG8_SCHED
}
}

#define LAS __attribute__((address_space(3)))
typedef unsigned short bf16_t;
typedef short bf16x8 __attribute__((ext_vector_type(8)));
typedef short s16x4 __attribute__((ext_vector_type(4)));
typedef float f32x4 __attribute__((ext_vector_type(4)));
typedef float f32x2 __attribute__((ext_vector_type(2)));
typedef float f32x16 __attribute__((ext_vector_type(16)));
typedef unsigned u32x4 __attribute__((ext_vector_type(4)));
typedef unsigned u32x2 __attribute__((ext_vector_type(2)));
typedef __bf16 bf16v2 __attribute__((ext_vector_type(2)));

constexpr int DM = 2048, SEQ = 2048, NBATCH = 16, MTOK = NBATCH * SEQ;
constexpr int NHEAD = 16, HD = 128;
constexpr int NA = 8192, NBP = 5120, RGW = 2560, NCF = 8208, NREL = 513;
constexpr float RMS_EPS = 1e-6f, LOG2E = 1.4426950408889634f;
constexpr float QSCALE = 0.08838834764831845f * 1.4426950408889634f;
constexpr size_t MiB = (size_t)1 << 20;
constexpr size_t WS_WA_IN = 0, WS_WA_OUT = 64 * MiB, WS_WB_IN = 80 * MiB, WS_WB_OUT = 100 * MiB, WS_WC_IN = 110 * MiB, WS_WC_OUT = 142 * MiB;
constexpr size_t WS_LOGF = 150 * MiB, WS_CUMB = 152 * MiB, WS_GW = 154 * MiB, WS_CTL = 156 * MiB, WS_BAR = WS_CTL, WS_CNT = WS_CTL + 65536, CTL_BYTES = 262144, WS_YS = 157 * MiB, WS_ACT = 160 * MiB, WS_PROJ = 320 * MiB, WS_XB = 832 * MiB, WS_XS = 960 * MiB, WS_END = 964 * MiB;
constexpr int LDS_BYTES = 147456;
constexpr int NPHASE = 17;

struct Params { const float* in[18]; float* out; unsigned char* ws; int ph_lo, ph_hi; };

__device__ __forceinline__ unsigned pk2(float a, float b) { const bf16v2 v = __builtin_convertvector((f32x2){a, b}, bf16v2); return __builtin_bit_cast(unsigned, v); }
__device__ __forceinline__ float bflo(unsigned w) { return __uint_as_float(w << 16); }
__device__ __forceinline__ float bfhi(unsigned w) { return __uint_as_float(w & 0xffff0000u); }
__device__ __forceinline__ float wave_sum(float v) {
#pragma unroll
    for (int o = 1; o < 64; o <<= 1) v += __shfl_xor(v, o);
    return v;
}
__device__ __forceinline__ float log1pexp_neg_abs(float x) { const float z = __builtin_amdgcn_exp2f(-LOG2E * __builtin_fabsf(x));
    const float ser = z * (1.0f - z * (0.5f - z * (0.33333334f - 0.25f * z))), lg = __builtin_amdgcn_logf(1.0f + z) * 0.6931471805599453f; return z < 0.06f ? ser : lg; }
__device__ __forceinline__ float fast_sigmoid(float z) { return __builtin_amdgcn_rcpf(1.0f + __builtin_amdgcn_exp2f(-LOG2E * z)); }

namespace pg8 {
__device__ __forceinline__ float slot_sum8(const float* s) { float t = 0.f;
#pragma unroll
    for (int q = 0; q < 8; ++q) t += s[q];
    return t; }
struct EpiProj {
    static constexpr bool PERM = true, AFTER_DRAIN = false;
    bf16_t* O; int ldc; int q_end; float qscale; int g_begin; const float* rstd;
    const LAS float* rs_lds;
    __device__ __forceinline__ void operator()(const f32x4 (&acc)[2][2][4][2], const Unit& u, int wr, int wc, int fr, int fq) const {
        const int row0 = u.pm * BM + wr * 64 + fr; const int colt = u.pn * BM;
        const int col0 = colt + wc * 32 + 8 * fq;
        const bool is_g = colt >= g_begin; const float sc = colt < q_end ? qscale : 1.0f;
#pragma unroll
        for (int ai = 0; ai < 2; ++ai)
#pragma unroll
            for (int m = 0; m < 4; ++m) { bf16_t* rowp = O + (size_t)(row0 + ai * HALF + m * 16) * ldc + col0;
                const float rs = rs_lds ? rs_lds[((u.pm >> 3) & 1) * 256 + wr * 64 + fr + ai * HALF + m * 16] * sc : (rstd ? sc / sqrtf(slot_sum8(rstd + (size_t)(row0 + ai * HALF + m * 16) * 8) * (1.0f / 2048.0f) + 1e-6f) : sc);
#pragma unroll
                for (int bj = 0; bj < 2; ++bj) { f32x4 v0 = acc[ai][bj][m][0] * rs, v1 = acc[ai][bj][m][1] * rs;
                    if (is_g) {
#pragma unroll
                        for (int j = 0; j < 4; ++j) { v0[j] = v0[j] * __builtin_amdgcn_rcpf(1.0f + __builtin_amdgcn_exp2f(-1.4426950408889634f * v0[j])); v1[j] = v1[j] * __builtin_amdgcn_rcpf(1.0f + __builtin_amdgcn_exp2f(-1.4426950408889634f * v1[j])); } }
                    u32x4 w; w.x = cvt_pk_bf16(v0[0], v0[1]); w.y = cvt_pk_bf16(v0[2], v0[3]); w.z = cvt_pk_bf16(v1[0], v1[1]); w.w = cvt_pk_bf16(v1[2], v1[3]);
                    __builtin_nontemporal_store(w, (u32x4*)(rowp + bj * HALF)); } }
    }
};
struct PanelOrder {
    int c;
    __device__ __forceinline__ bool next(int i, Unit& u) const { if (i >= 4) return false; const int x = c & 7, j = c >> 3; u.pm = 16 * x + 4 * i + (j >> 3); u.pn = j & 7; return true; }
    __device__ __forceinline__ void a_ready(const Unit&) const {}
    __device__ __forceinline__ void done(const Unit&) const {}
};
constexpr size_t FUSE_XB = (size_t)832 << 20, FUSE_XS = (size_t)960 << 20, FUSE_YS = (size_t)157 << 20, FUSE_CNT = ((size_t)156 << 20) + 65536;
struct EpiFuse {
    static constexpr bool PERM = true, AFTER_DRAIN = false;
    unsigned char* wsb; float* out32; const float* gpost; int layer; PG8_LAS float* P;
    __device__ __forceinline__ void operator()(const f32x4 (&acc)[2][2][4][2], const Unit& u, int wr, int wc, int fr, int fq) const {
        bf16_t* XBp = (bf16_t*)(wsb + FUSE_XB); float* ys = (float*)(wsb + FUSE_YS); float* xs_next = layer < 3 ? (float*)(wsb + FUSE_XS) + (size_t)(layer + 1) * 32768 * 8 : nullptr; unsigned* cnt = (unsigned*)(wsb + FUSE_CNT) + (size_t)layer * 128 * 64;
        const int rp0 = wr * 64 + fr, row0 = u.pm * BM + rp0, col0 = u.pn * BM + wc * 32 + 8 * fq, tid = threadIdx.x;
        PG8_LAS float* S = P + 1024;
#pragma unroll
        for (int ai = 0; ai < 2; ++ai)
#pragma unroll
            for (int m = 0; m < 4; ++m) { float s = 0.f;
#pragma unroll
                for (int bj = 0; bj < 2; ++bj)
#pragma unroll
                    for (int n = 0; n < 2; ++n) { const f32x4 x = acc[ai][bj][m][n]; s += (x[0] * x[0] + x[1] * x[1]) + (x[2] * x[2] + x[3] * x[3]); }
                s += __shfl_xor(s, 16); s += __shfl_xor(s, 32);
                if (fq == 0) P[(rp0 + ai * HALF + m * 16) * 4 + wc] = s; }
        asm volatile("s_waitcnt lgkmcnt(0)" ::: "memory"); __builtin_amdgcn_s_barrier(); asm volatile("" ::: "memory");
        if (tid < 256) { const float t4 = (P[tid * 4 + 0] + P[tid * 4 + 1]) + (P[tid * 4 + 2] + P[tid * 4 + 3]);
            __hip_atomic_store(ys + (size_t)(u.pm * BM + tid) * 8 + u.pn, t4, __ATOMIC_RELAXED, __HIP_MEMORY_SCOPE_AGENT); }
        asm volatile("s_waitcnt vmcnt(0)" ::: "memory");
        unsigned* cw = cnt + 64 * u.pm;
        if ((tid & 63) == 0) (void)__hip_atomic_fetch_add(cw, 1u, __ATOMIC_RELAXED, __HIP_MEMORY_SCOPE_AGENT);
        { unsigned spins = 0;
          while ((unsigned)__builtin_amdgcn_readfirstlane(__hip_atomic_load(cw, __ATOMIC_RELAXED, __HIP_MEMORY_SCOPE_AGENT)) < 64u) { __builtin_amdgcn_s_sleep(2); if (++spins > (1u << 22)) break; } }
        asm volatile("" ::: "memory");
        if (tid < 256) { const float* sl = ys + (size_t)(u.pm * BM + tid) * 8; float t8 = 0.f;
#pragma unroll
            for (int q = 0; q < 8; ++q) t8 += __hip_atomic_load(sl + q, __ATOMIC_RELAXED, __HIP_MEMORY_SCOPE_AGENT);
            S[tid] = 1.0f / sqrtf(t8 * (1.0f / 2048.0f) + 1e-6f); }
        asm volatile("s_waitcnt vmcnt(0) lgkmcnt(0)" ::: "memory"); __builtin_amdgcn_s_barrier(); asm volatile("" ::: "memory");
        float g[2][8];
#pragma unroll
        for (int bj = 0; bj < 2; ++bj) { const f32x4 a = *(const f32x4*)(gpost + col0 + bj * HALF), b = *(const f32x4*)(gpost + col0 + bj * HALF + 4);
            g[bj][0] = a[0]; g[bj][1] = a[1]; g[bj][2] = a[2]; g[bj][3] = a[3]; g[bj][4] = b[0]; g[bj][5] = b[1]; g[bj][6] = b[2]; g[bj][7] = b[3]; }
#pragma unroll
        for (int ai = 0; ai < 2; ++ai) {
            u32x4 xw[4][2];
#pragma unroll
            for (int m = 0; m < 4; ++m)
#pragma unroll
                for (int bj = 0; bj < 2; ++bj) xw[m][bj] = *(const u32x4*)(XBp + (size_t)(u.pm * BM + rp0 + ai * HALF + m * 16) * 2048 + col0 + bj * HALF);
#pragma unroll
            for (int m = 0; m < 4; ++m) { const int rp = rp0 + ai * HALF + m * 16, row = u.pm * BM + rp;
                const float ry = S[rp];
                float s2 = 0.f;
#pragma unroll
                for (int bj = 0; bj < 2; ++bj) { bf16_t* xp = XBp + (size_t)row * 2048 + col0 + bj * HALF;
                    const u32x4 xv = xw[m][bj]; float o[8];
                    o[0] = __uint_as_float(xv.x << 16); o[1] = __uint_as_float(xv.x & 0xffff0000u); o[2] = __uint_as_float(xv.y << 16); o[3] = __uint_as_float(xv.y & 0xffff0000u);
                    o[4] = __uint_as_float(xv.z << 16); o[5] = __uint_as_float(xv.z & 0xffff0000u); o[6] = __uint_as_float(xv.w << 16); o[7] = __uint_as_float(xv.w & 0xffff0000u);
#pragma unroll
                    for (int e = 0; e < 8; ++e) { o[e] += acc[ai][bj][m][e >> 2][e & 3] * ry * g[bj][e]; s2 += o[e] * o[e]; }
                    if (out32) { float* op = out32 + (size_t)row * 2048 + col0 + bj * HALF; *(f32x4*)op = (f32x4){o[0], o[1], o[2], o[3]}; *(f32x4*)(op + 4) = (f32x4){o[4], o[5], o[6], o[7]}; }
                    else { u32x4 w; w.x = cvt_pk_bf16(o[0], o[1]); w.y = cvt_pk_bf16(o[2], o[3]); w.z = cvt_pk_bf16(o[4], o[5]); w.w = cvt_pk_bf16(o[6], o[7]); *(u32x4*)xp = w; } }
                if (xs_next) { s2 += __shfl_xor(s2, 16); s2 += __shfl_xor(s2, 32); if (fq == 0) P[rp * 4 + wc] = s2; } }
            asm volatile("" ::: "memory");
        }
        if (xs_next) {
            asm volatile("s_waitcnt lgkmcnt(0)" ::: "memory"); __builtin_amdgcn_s_barrier(); asm volatile("" ::: "memory");
            if (tid < 256) xs_next[(size_t)(u.pm * BM + tid) * 8 + u.pn] = (P[tid * 4 + 0] + P[tid * 4 + 1]) + (P[tid * 4 + 2] + P[tid * 4 + 3]);
            asm volatile("s_waitcnt lgkmcnt(0)" ::: "memory"); __builtin_amdgcn_s_barrier(); asm volatile("" ::: "memory");
        }
    }
};
template <class Epi, class Sched, bool ALIGN_EPI = false, bool SP2 = false>
__device__ __forceinline__ void gemm_phase2(PG8_LAS unsigned char* lds, const Gemm g, const Sched& S, const Epi& E, const int tid_in) {
    const int tid = tid_in, wid = __builtin_amdgcn_readfirstlane(tid >> 6), lane = tid & 63, wr = wid >> 2, wc = wid & 3, fr = lane & 15, fq = lane >> 4;
    const int K = g.K, nt = K / BK;
    unsigned voffA[2], voffB[2];
#pragma unroll
    for (int i = 0; i < 2; ++i) { int R, C; stage_rc(tid * 16 + i * 8192, R, C); const int Rb = Epi::PERM ? ((R & ~31) + perm32(R & 31)) : R;
        voffA[i] = (unsigned)(R * K + C) * 2u; voffB[i] = (unsigned)(Rb * K + C) * 2u; }
    const size_t kstep = (size_t)(BK * 2);
    const size_t hstep = (size_t)HALF * K * 2;
    const size_t tstep = 2 * hstep;
    const unsigned ldsw = (unsigned)wid * 1024u;
    const int aoff = lds_byte(wr * 64 + fr, fq * 8), boff = lds_byte(wc * 32 + fr, fq * 8);
#define PG8_SA(b, h) (((b) * 2 + (h)) * HTB)
#define PG8_SB(b, h) ((4 + (b) * 2 + (h)) * HTB)
#define PG8_STAGE(bufoff, gbase, voff) do { _Pragma("unroll") for (int _i = 0; _i < 2; ++_i) \
        __builtin_amdgcn_global_load_lds((const unsigned*)((const char*)(gbase) + (voff)[_i]), (PG8_LAS unsigned*)(lds + (bufoff) + ldsw + _i * 8192), 16, 0, 0); } while (0)
#define PG8_LDA(dst, b, h) do { _Pragma("unroll") for (int m = 0; m < 4; ++m) _Pragma("unroll") for (int k = 0; k < 2; ++k) dst[m][k] = *(const PG8_LAS bf16x8*)(lds + PG8_SA(b, h) + aoff + m * 2048 + k * 1024); } while (0)
#define PG8_LDB(dst, b, h) do { _Pragma("unroll") for (int n = 0; n < 2; ++n) _Pragma("unroll") for (int k = 0; k < 2; ++k) dst[n][k] = *(const PG8_LAS bf16x8*)(lds + PG8_SB(b, h) + boff + n * 2048 + k * 1024); } while (0)
#define PG8_MMA(ai, bj, At, Bt) do { __builtin_amdgcn_s_setprio(1); _Pragma("unroll") for (int m = 0; m < 4; ++m) _Pragma("unroll") for (int n = 0; n < 2; ++n) _Pragma("unroll") for (int k = 0; k < 2; ++k) \
        acc[ai][bj][m][n] = __builtin_amdgcn_mfma_f32_16x16x32_bf16(Bt[n][k], At[m][k], acc[ai][bj][m][n], 0, 0, 0); __builtin_amdgcn_s_setprio(0); } while (0)
#define PG8_WAIT_V(n) asm volatile("s_waitcnt vmcnt(" #n ")" ::: "memory")
#define PG8_WAIT_L(n) asm volatile("s_waitcnt lgkmcnt(" #n ")" ::: "memory")
#define PG8_BAR __builtin_amdgcn_s_barrier()
#define PG8_SCHED __builtin_amdgcn_sched_barrier(0)
    Unit cur, nxt; int ui = 0;
    if (!S.next(0, cur)) return;
    f32x4 acc[2][2][4][2];
#pragma unroll
    for (int a = 0; a < 2; ++a)
#pragma unroll
        for (int b = 0; b < 2; ++b)
#pragma unroll
            for (int m = 0; m < 4; ++m)
#pragma unroll
                for (int n = 0; n < 2; ++n) acc[a][b][m][n] = (f32x4){0.f, 0.f, 0.f, 0.f};
    bf16x8 At[4][2], B0[2][2], B1[2][2];
    const char* cA = (const char*)g.A + (size_t)cur.pm * tstep; const char* cB = (const char*)g.Bt + (size_t)cur.pn * tstep;
    S.a_ready(cur);
    if constexpr (SP2) {
        PG8_STAGE(PG8_SB(0, 0), cB, voffB); PG8_STAGE(PG8_SB(0, 1), cB + hstep, voffB); PG8_STAGE(PG8_SA(0, 0), cA, voffA); PG8_STAGE(PG8_SA(0, 1), cA + hstep, voffA);
        if (wr == 1) PG8_BAR;
        PG8_WAIT_V(2); PG8_BAR;
        PG8_STAGE(PG8_SB(1, 0), cB + kstep, voffB); PG8_STAGE(PG8_SA(1, 0), cA + kstep, voffA); PG8_STAGE(PG8_SB(1, 1), cB + hstep + kstep, voffB);
        PG8_WAIT_V(6); PG8_BAR;
    } else {
        PG8_STAGE(PG8_SB(0, 0), cB, voffB); PG8_STAGE(PG8_SA(0, 0), cA, voffA); PG8_STAGE(PG8_SB(0, 1), cB + hstep, voffB); PG8_STAGE(PG8_SA(0, 1), cA + hstep, voffA);
        if (wr == 1) PG8_BAR;
        PG8_WAIT_V(4); PG8_BAR;
        PG8_STAGE(PG8_SB(1, 0), cB + kstep, voffB); PG8_STAGE(PG8_SA(1, 0), cA + kstep, voffA); PG8_STAGE(PG8_SB(1, 1), cB + hstep + kstep, voffB);
        PG8_WAIT_V(6); PG8_BAR;
    }
    for (;;) {
        const bool has_next = S.next(ui + 1, nxt);
        const char* nA = has_next ? (const char*)g.A + (size_t)nxt.pm * tstep : cA; const char* nB = has_next ? (const char*)g.Bt + (size_t)nxt.pn * tstep : cB;
        for (int t = 0; t < nt; t += 2) {
            const bool last = (t == nt - 2);
            const char* a1 = cA + (size_t)(t + 1) * kstep;
            const char* a2 = last ? nA : cA + (size_t)(t + 2) * kstep; const char* b2 = last ? nB : cB + (size_t)(t + 2) * kstep;
            const char* a3 = a2 + kstep; const char* b3 = b2 + kstep;
            if (last && has_next) S.a_ready(nxt);
            if constexpr (SP2) {
            PG8_LDB(B0, 0, 0); PG8_LDB(B1, 0, 1); PG8_SCHED; PG8_LDA(At, 0, 0); PG8_STAGE(PG8_SA(1, 1), a1 + hstep, voffA);
            PG8_WAIT_V(8); PG8_WAIT_L(0); PG8_BAR; PG8_MMA(0, 0, At, B0); PG8_MMA(0, 1, At, B1); PG8_BAR; PG8_SCHED;
            PG8_LDA(At, 0, 1); PG8_STAGE(PG8_SB(0, 0), b2, voffB); PG8_STAGE(PG8_SB(0, 1), b2 + hstep, voffB); PG8_STAGE(PG8_SA(0, 0), a2, voffA);
            PG8_WAIT_V(8); PG8_WAIT_L(0); PG8_BAR; PG8_MMA(1, 0, At, B0); PG8_MMA(1, 1, At, B1); PG8_BAR; PG8_SCHED;
            PG8_LDB(B0, 1, 0); PG8_LDB(B1, 1, 1); PG8_SCHED; PG8_LDA(At, 1, 0); PG8_STAGE(PG8_SA(0, 1), a2 + hstep, voffA);
            PG8_WAIT_V(8); PG8_WAIT_L(0); PG8_BAR; PG8_MMA(0, 0, At, B0); PG8_MMA(0, 1, At, B1); PG8_BAR; PG8_SCHED;
            PG8_LDA(At, 1, 1); PG8_STAGE(PG8_SB(1, 0), b3, voffB); PG8_STAGE(PG8_SB(1, 1), b3 + hstep, voffB); PG8_STAGE(PG8_SA(1, 0), a3, voffA);
            PG8_WAIT_V(8); PG8_WAIT_L(0); PG8_BAR; PG8_MMA(1, 0, At, B0); PG8_MMA(1, 1, At, B1); PG8_BAR; PG8_SCHED;
            } else {
            PG8_LDB(B0, 0, 0); PG8_SCHED; PG8_LDA(At, 0, 0); PG8_STAGE(PG8_SA(1, 1), a1 + hstep, voffA);
            PG8_WAIT_L(8); PG8_BAR; PG8_WAIT_L(0); PG8_MMA(0, 0, At, B0); PG8_BAR; PG8_SCHED;
            PG8_LDB(B1, 0, 1); PG8_STAGE(PG8_SB(0, 0), b2, voffB);
            PG8_BAR; PG8_WAIT_L(0); PG8_MMA(0, 1, At, B1); PG8_BAR;
            PG8_LDA(At, 0, 1); PG8_STAGE(PG8_SA(0, 0), a2, voffA);
            PG8_BAR; PG8_WAIT_L(0); PG8_MMA(1, 0, At, B0); PG8_BAR; PG8_SCHED;
            PG8_STAGE(PG8_SB(0, 1), b2 + hstep, voffB);
            PG8_WAIT_V(6); PG8_BAR; PG8_MMA(1, 1, At, B1); PG8_BAR;
            PG8_LDB(B0, 1, 0); PG8_SCHED; PG8_LDA(At, 1, 0); PG8_STAGE(PG8_SA(0, 1), a2 + hstep, voffA);
            PG8_WAIT_L(8); PG8_BAR; PG8_WAIT_L(0); PG8_MMA(0, 0, At, B0); PG8_BAR; PG8_SCHED;
            PG8_LDB(B1, 1, 1); PG8_STAGE(PG8_SB(1, 0), b3, voffB);
            PG8_BAR; PG8_WAIT_L(0); PG8_MMA(0, 1, At, B1); PG8_BAR;
            PG8_LDA(At, 1, 1); PG8_STAGE(PG8_SA(1, 0), a3, voffA);
            PG8_BAR; PG8_WAIT_L(0); PG8_MMA(1, 0, At, B0); PG8_BAR; PG8_SCHED;
            PG8_STAGE(PG8_SB(1, 1), b3 + hstep, voffB);
            PG8_WAIT_V(6); PG8_BAR; PG8_MMA(1, 1, At, B1); PG8_BAR;
            }
        }
        if constexpr (ALIGN_EPI) { if (wr == 0) PG8_BAR; }
        if constexpr (!Epi::AFTER_DRAIN) { E(acc, cur, wr, wc, fr, fq); S.done(cur); }
        if (!has_next) break;
#pragma unroll
        for (int a = 0; a < 2; ++a)
#pragma unroll
            for (int b = 0; b < 2; ++b)
#pragma unroll
                for (int m = 0; m < 4; ++m)
#pragma unroll
                    for (int n = 0; n < 2; ++n) acc[a][b][m][n] = (f32x4){0.f, 0.f, 0.f, 0.f};
        cur = nxt; cA = nA; cB = nB; ++ui;
        if constexpr (ALIGN_EPI) { if (wr == 1) PG8_BAR; }
    }
    PG8_WAIT_V(0);
    if constexpr (!ALIGN_EPI) { if (wr == 0) PG8_BAR; }
    PG8_BAR;
    if constexpr (Epi::AFTER_DRAIN) { E.fused(acc, cur, wr, wc, fr, fq, lds, wid, lane); S.done(cur); }
#undef PG8_SA
#undef PG8_SB
#undef PG8_STAGE
#undef PG8_LDA
#undef PG8_LDB
#undef PG8_MMA
#undef PG8_WAIT_V
#undef PG8_WAIT_L
#undef PG8_BAR
#undef PG8_SCHED
}

}

__device__ __forceinline__ void transpose_item(const float* W, int ldw, int nblk, int K, bf16_t* WT, LAS float* scr, int item, int lane, const float* g) {
    const int kb = item / nblk, nb = item - kb * nblk, k0 = 64 * kb, n0 = 32 * nb;
#pragma unroll
    for (int i = 0; i < 8; ++i) { const int kk = 8 * i + (lane >> 3), q = lane & 7;
        const f32x4 v = *(const f32x4*)(W + (size_t)(k0 + kk) * ldw + n0 + 4 * q); LAS float* d = scr + kk * 33 + 4 * q; d[0] = v.x; d[1] = v.y; d[2] = v.z; d[3] = v.w; }
    asm volatile("s_waitcnt lgkmcnt(0)" ::: "memory");
    const int c = lane & 7;
    f32x4 ga = {1.f, 1.f, 1.f, 1.f}, gb = ga;
    if (g) { ga = *(const f32x4*)(g + k0 + 8 * c); gb = *(const f32x4*)(g + k0 + 8 * c + 4); }
#pragma unroll
    for (int j = 0; j < 4; ++j) { const int n = (lane >> 3) + 8 * j; const LAS float* s = scr + (8 * c) * 33 + n;
        u32x4 o; o.x = pk2(s[0 * 33] * ga[0], s[1 * 33] * ga[1]); o.y = pk2(s[2 * 33] * ga[2], s[3 * 33] * ga[3]); o.z = pk2(s[4 * 33] * gb[0], s[5 * 33] * gb[1]); o.w = pk2(s[6 * 33] * gb[2], s[7 * 33] * gb[3]);
        *(u32x4*)(WT + (size_t)(n0 + n) * K + k0 + 8 * c) = o; }
    asm volatile("s_waitcnt lgkmcnt(0)" ::: "memory");
}
__device__ __forceinline__ void norm_row_to_bf16(const float* xrow, float* rstd_out, bf16_t* orow, int lane) {
    f32x4 v[4][2]; float s = 0.f;
#pragma unroll
    for (int j = 0; j < 4; ++j)
#pragma unroll
        for (int q = 0; q < 2; ++q) { v[j][q] = *(const f32x4*)(xrow + 8 * lane + 512 * j + 4 * q); s += (v[j][q].x * v[j][q].x + v[j][q].y * v[j][q].y) + (v[j][q].z * v[j][q].z + v[j][q].w * v[j][q].w); }
    const float ssq = wave_sum(s);
    float zz = 0.f; asm volatile("" : "+v"(zz));
    if (lane == 0) { *(f32x4*)rstd_out = (f32x4){ssq, zz, zz, zz}; *(f32x4*)(rstd_out + 4) = (f32x4){zz, zz, zz, zz}; }
#pragma unroll
    for (int j = 0; j < 4; ++j) { u32x4 w; w.x = pk2(v[j][0].x, v[j][0].y); w.y = pk2(v[j][0].z, v[j][0].w); w.z = pk2(v[j][1].x, v[j][1].y); w.w = pk2(v[j][1].z, v[j][1].w);
        *(u32x4*)(orow + 8 * lane + 512 * j) = w; }
}
__device__ __forceinline__ void prologue_phase(const Params& p, LAS unsigned char* L, int G, int blk, int wave, int lane) {
    LAS float* scr = (LAS float*)(L + wave * 16384);
    const int gw = blk * 8 + wave, NGW = G * 8;
    unsigned char* ws = p.ws;
    constexpr int I_AIN = 32 * 256, I_AOUT = 32 * 64, I_BIN = 32 * 160, I_BOUT = 40 * 64, I_CIN = 32 * 256, I_COUT = 32 * 64;
    constexpr int NITEMS = 2 * I_AIN + 2 * I_AOUT + I_BIN + I_BOUT + I_CIN + I_COUT;
    for (int it = gw; it < NITEMS; it += NGW) {
        int r = it;
        if (r < I_AIN) { transpose_item(p.in[3], NA, 256, DM, (bf16_t*)(ws + WS_WA_IN), scr, r, lane, p.in[1]); continue; } r -= I_AIN;
        if (r < I_AOUT) { transpose_item(p.in[5], DM, 64, DM, (bf16_t*)(ws + WS_WA_OUT), scr, r, lane, nullptr); continue; } r -= I_AOUT;
        if (r < I_BIN) { transpose_item(p.in[6], NBP, 160, DM, (bf16_t*)(ws + WS_WB_IN), scr, r, lane, p.in[1] + DM); continue; } r -= I_BIN;
        if (r < I_BOUT) { transpose_item(p.in[14], DM, 64, RGW, (bf16_t*)(ws + WS_WB_OUT), scr, r, lane, nullptr); continue; } r -= I_BOUT;
        if (r < I_CIN) { transpose_item(p.in[15], NCF, 256, DM, (bf16_t*)(ws + WS_WC_IN), scr, r, lane, p.in[1] + 2 * DM); continue; } r -= I_CIN;
        if (r < I_COUT) { transpose_item(p.in[17], DM, 64, DM, (bf16_t*)(ws + WS_WC_OUT), scr, r, lane, nullptr); continue; } r -= I_COUT;
        if (r < I_AIN) { transpose_item(p.in[3] + (size_t)DM * NA, NA, 256, DM, (bf16_t*)(ws + WS_WA_IN + 32 * MiB), scr, r, lane, p.in[1] + 3 * DM); continue; } r -= I_AIN;
        transpose_item(p.in[5] + (size_t)DM * DM, DM, 64, DM, (bf16_t*)(ws + WS_WA_OUT + 8 * MiB), scr, r, lane, nullptr);
    }
    for (int it = gw * 64 + lane; it < 2 * 16 * 10 * 5 * 64; it += NGW * 64) { const int l = it & 63, f = it >> 6, ks = f % 5, ct = (f / 5) % 10, nb = (f / 50) % 16, gate = f / 800;
        const float* src = (gate ? p.in[11] : p.in[9]) + (size_t)nb * 25600 + (32 * ks + 8 * (l >> 4)) * 160 + ct * 16 + (l & 15);
        u32x4 o; o.x = pk2(src[0], src[160]); o.y = pk2(src[320], src[480]); o.z = pk2(src[640], src[800]); o.w = pk2(src[960], src[1120]);
        *(u32x4*)(ws + WS_GW + (size_t)it * 16) = o; }
    bf16_t* XB = (bf16_t*)(ws + WS_XB); float* RSTD = (float*)(ws + WS_XS);
    for (int m = gw; m < MTOK; m += NGW) norm_row_to_bf16(p.in[0] + (size_t)m * DM, RSTD + (size_t)m * 8, XB + (size_t)m * DM, lane);
}

__device__ __forceinline__ void unpack8(const u32x4 w, float (&o)[8]) { o[0] = bflo(w.x); o[1] = bfhi(w.x); o[2] = bflo(w.y); o[3] = bfhi(w.y); o[4] = bflo(w.z); o[5] = bfhi(w.z); o[6] = bflo(w.w); o[7] = bfhi(w.w); }
template <int NR, bool XF32>
__device__ __forceinline__ void row_phase(const bf16_t* Y, const float* xin32, bf16_t* XB, float* out32, const float* gpost, float* RSTD, const float* gpre,
                                          const float* wf, const float* fbias, float* LOGF, int gw, int NGW, int lane, LAS float* WL, int tid) {
    if (wf) {
        for (int i = tid; i < DM * 4; i += 512) { const int d = i >> 2, q = i & 3; const f32x4 v4 = *(const f32x4*)(wf + (size_t)d * NCF + 4 * q);
            const int slot = (((d >> 9) * 8 + (d & 7)) * 64 + ((d & 511) >> 3)); *(LAS f32x4*)(WL + slot * 16 + 4 * q) = v4; }
        __syncthreads();
    }
    float gp[4][8];
#pragma unroll
    for (int j = 0; j < 4; ++j) { const f32x4 a = *(const f32x4*)(gpost + 8 * lane + 512 * j), b = *(const f32x4*)(gpost + 8 * lane + 512 * j + 4);
        gp[j][0] = a.x; gp[j][1] = a.y; gp[j][2] = a.z; gp[j][3] = a.w; gp[j][4] = b.x; gp[j][5] = b.y; gp[j][6] = b.z; gp[j][7] = b.w; }
    for (int m0 = gw; m0 < MTOK; m0 += NGW * NR) {
        u32x4 yw[NR][4], xw[XF32 ? 1 : NR][4]; f32x4 xf[XF32 ? NR : 1][4][2];
#pragma unroll
        for (int r = 0; r < NR; ++r) { const int m = m0 + r * NGW;
            if (m < MTOK) {
#pragma unroll
                for (int j = 0; j < 4; ++j) yw[r][j] = *(const u32x4*)(Y + (size_t)m * DM + 8 * lane + 512 * j);
                if (XF32) {
#pragma unroll
                    for (int j = 0; j < 4; ++j) { xf[XF32 ? r : 0][j][0] = *(const f32x4*)(xin32 + (size_t)m * DM + 8 * lane + 512 * j); xf[XF32 ? r : 0][j][1] = *(const f32x4*)(xin32 + (size_t)m * DM + 8 * lane + 512 * j + 4); }
                } else {
#pragma unroll
                    for (int j = 0; j < 4; ++j) xw[XF32 ? 0 : r][j] = *(const u32x4*)(XB + (size_t)m * DM + 8 * lane + 512 * j);
                } } }
#pragma unroll
        for (int r = 0; r < NR; ++r) { const int m = m0 + r * NGW; if (m >= MTOK) break;
            float v[4][8]; float s = 0.f;
#pragma unroll
            for (int j = 0; j < 4; ++j) { unpack8(yw[r][j], v[j]);
#pragma unroll
                for (int e = 0; e < 8; ++e) s += v[j][e] * v[j][e]; }
            const float rstd_y = 1.0f / sqrtf(wave_sum(s) * (1.0f / DM) + RMS_EPS);
            float s2 = 0.f;
#pragma unroll
            for (int j = 0; j < 4; ++j) { float xx[8];
                if (XF32) { const int rr = XF32 ? r : 0; xx[0] = xf[rr][j][0].x; xx[1] = xf[rr][j][0].y; xx[2] = xf[rr][j][0].z; xx[3] = xf[rr][j][0].w; xx[4] = xf[rr][j][1].x; xx[5] = xf[rr][j][1].y; xx[6] = xf[rr][j][1].z; xx[7] = xf[rr][j][1].w; }
                else unpack8(xw[XF32 ? 0 : r][j], xx);
#pragma unroll
                for (int e = 0; e < 8; ++e) { v[j][e] = xx[e] + v[j][e] * rstd_y * gp[j][e]; s2 += v[j][e] * v[j][e]; } }
            if (out32) {
#pragma unroll
                for (int j = 0; j < 4; ++j) { *(f32x4*)(out32 + (size_t)m * DM + 8 * lane + 512 * j) = (f32x4){v[j][0], v[j][1], v[j][2], v[j][3]}; *(f32x4*)(out32 + (size_t)m * DM + 8 * lane + 512 * j + 4) = (f32x4){v[j][4], v[j][5], v[j][6], v[j][7]}; }
            } else {
                const float ssq2 = wave_sum(s2); const float rstd = 1.0f / sqrtf(ssq2 * (1.0f / DM) + RMS_EPS);
                if (lane == 0) { *(f32x4*)(RSTD + (size_t)m * 8) = (f32x4){ssq2, 0.f, 0.f, 0.f}; *(f32x4*)(RSTD + (size_t)m * 8 + 4) = (f32x4){0.f, 0.f, 0.f, 0.f}; }
#pragma unroll
                for (int j = 0; j < 4; ++j) { u32x4 w; w.x = pk2(v[j][0], v[j][1]); w.y = pk2(v[j][2], v[j][3]); w.z = pk2(v[j][4], v[j][5]); w.w = pk2(v[j][6], v[j][7]); *(u32x4*)(XB + (size_t)m * DM + 8 * lane + 512 * j) = w; }
                if (wf) {
                    f32x4 a0 = {0.f, 0.f, 0.f, 0.f}, a1 = a0, a2 = a0, a3 = a0;
                    int lo = lane; asm volatile("" : "+v"(lo));
#pragma unroll
                    for (int j = 0; j < 4; ++j)
#pragma unroll
                        for (int e = 0; e < 8; ++e) { const int d = 8 * lo + 512 * j + e; const LAS f32x4* wp = (const LAS f32x4*)(WL + ((j * 8 + e) * 64 + lo) * 16); const float hv = v[j][e] * rstd * gpre[d];
                            a0 += wp[0] * hv; a1 += wp[1] * hv; a2 += wp[2] * hv; a3 += wp[3] * hv;
                            if ((e & 3) == 3) asm volatile("" ::: "memory"); }
                    float mine = 0.f;
#pragma unroll
                    for (int q = 0; q < 4; ++q) { const float t0 = wave_sum(a0[q]), t1 = wave_sum(a1[q]), t2 = wave_sum(a2[q]), t3 = wave_sum(a3[q]);
                        mine = lane == q ? t0 : mine; mine = lane == 4 + q ? t1 : mine; mine = lane == 8 + q ? t2 : mine; mine = lane == 12 + q ? t3 : mine; }
                    if (lane < 16) { const float z = mine + fbias[lane]; const float lf = fminf(z, 0.f) - log1pexp_neg_abs(z); LOGF[(size_t)m * 16 + lane] = lf; }
                }
            }
        }
    }
}

__device__ __forceinline__ void flogit_phase(const bf16_t* XB, const float* xs, const float* gpre, const float* wf, const float* fbias, float* LOGF, int gw, int NGW, int lane, LAS float* WL, int tid) {
    for (int i = tid; i < DM * 4; i += 512) { const int d = i >> 2, q = i & 3; const f32x4 v4 = *(const f32x4*)(wf + (size_t)d * NCF + 4 * q);
        const int slot = (((d >> 9) * 8 + (d & 7)) * 64 + ((d & 511) >> 3)); *(LAS f32x4*)(WL + slot * 16 + 4 * q) = v4; }
    __syncthreads();
    float gp[4][8];
#pragma unroll
    for (int j = 0; j < 4; ++j) { const f32x4 a = *(const f32x4*)(gpre + 8 * lane + 512 * j), b = *(const f32x4*)(gpre + 8 * lane + 512 * j + 4);
        gp[j][0] = a.x; gp[j][1] = a.y; gp[j][2] = a.z; gp[j][3] = a.w; gp[j][4] = b.x; gp[j][5] = b.y; gp[j][6] = b.z; gp[j][7] = b.w; }
    for (int m = gw; m < MTOK; m += NGW) {
        u32x4 xw[4];
#pragma unroll
        for (int j = 0; j < 4; ++j) xw[j] = *(const u32x4*)(XB + (size_t)m * DM + 8 * lane + 512 * j);
        const float rstd = 1.0f / sqrtf(pg8::slot_sum8(xs + (size_t)m * 8) * (1.0f / DM) + RMS_EPS);
        f32x4 a0 = {0.f, 0.f, 0.f, 0.f}, a1 = a0, a2 = a0, a3 = a0;
        int lo = lane; asm volatile("" : "+v"(lo));
#pragma unroll
        for (int j = 0; j < 4; ++j) { float v[8]; unpack8(xw[j], v);
#pragma unroll
            for (int e = 0; e < 8; ++e) { const LAS f32x4* wp = (const LAS f32x4*)(WL + ((j * 8 + e) * 64 + lo) * 16); const float hv = v[e] * rstd * gp[j][e];
                a0 += wp[0] * hv; a1 += wp[1] * hv; a2 += wp[2] * hv; a3 += wp[3] * hv;
                if ((e & 3) == 3) asm volatile("" ::: "memory"); } }
        float mine = 0.f;
#pragma unroll
        for (int q = 0; q < 4; ++q) { const float t0 = wave_sum(a0[q]), t1 = wave_sum(a1[q]), t2 = wave_sum(a2[q]), t3 = wave_sum(a3[q]);
            mine = lane == q ? t0 : mine; mine = lane == 4 + q ? t1 : mine; mine = lane == 8 + q ? t2 : mine; mine = lane == 12 + q ? t3 : mine; }
        if (lane < 16) { const float z = mine + fbias[lane]; const float lf = fminf(z, 0.f) - log1pexp_neg_abs(z); LOGF[(size_t)m * 16 + lane] = lf; }
    }
}

__device__ __forceinline__ void cumsum_phase(const float* LOGF, float* CUMB, LAS float* sc, int G, int blk, int tid) {
    const int lane = tid & 63, wave = tid >> 6;
    for (int bh = blk; bh < NBATCH * NHEAD; bh += G) {
        const int b = bh >> 4, hh = bh & 15; const int t0 = 4 * tid;
        float v[4];
#pragma unroll
        for (int e = 0; e < 4; ++e) v[e] = LOGF[((size_t)(b * SEQ + t0 + e)) * 16 + hh];
        v[1] += v[0]; v[2] += v[1]; v[3] += v[2];
        float incl = v[3];
#pragma unroll
        for (int o = 1; o < 64; o <<= 1) { const float t = __shfl_up(incl, o); if (lane >= o) incl += t; }
        if (lane == 63) sc[wave] = incl;
        __syncthreads();
        float woff = 0.f;
        for (int i = 0; i < wave; ++i) woff += sc[i];
        const float excl = incl - v[3] + woff;
        f32x4 o; o.x = -(excl + v[0]) * LOG2E; o.y = -(excl + v[1]) * LOG2E; o.z = -(excl + v[2]) * LOG2E; o.w = -(excl + v[3]) * LOG2E;
        *(f32x4*)(CUMB + (size_t)bh * SEQ + t0) = o;
        __syncthreads();
    }
}

__device__ __forceinline__ unsigned off_b(unsigned row, unsigned ch) { return 256u * row + 16u * (ch ^ (((row & 3u) << 2) | ((row >> 2) & 3u))); }
#define MFMA32(a, b, c) __builtin_amdgcn_mfma_f32_32x32x16_bf16((a), (b), (c), 0, 0, 0)
template <int MODE>
__device__ __forceinline__ void attn_phase(LAS unsigned char* L, const bf16_t* PROJ, bf16_t* ACT, const float* bias_src, int G, int blk, const int tid) {
    const int  lane = tid & 63, w = __builtin_amdgcn_readfirstlane(tid >> 6), c = lane & 31, hi = lane >> 5;
    LAS float* T = (LAS float*)(L + 65536);
    const int srow = tid >> 4, sch = tid & 15;
    const unsigned soff0 = off_b(srow, sch), soff1 = off_b(srow + 32, sch);
    const unsigned kaddr = 256u * c + 16u * ((unsigned)hi ^ (((c & 3u) << 2) | ((c >> 2) & 3u)));
    const unsigned blk16 = (lane >> 4) & 1, q4 = (lane & 15) >> 2, p4 = lane & 3;
    const unsigned vbase0 = 256u * (4u * hi + q4) + 8u * (p4 & 1u);
    const unsigned vb = 64u * q4 + 16u * (((2u * blk16 + (p4 >> 1)) ^ (unsigned)hi));
    const int nit = G == 256 ? 8 : (NBATCH * NHEAD * 8 + G - 1) / G;
    for (int it = 0; it < nit; ++it) {
        int bh, qb;
        if (G == 256) { const int x = blk & 7, j = blk >> 3; bh = x * 32 + (7 - it) * 4 + (j >> 3); qb = (j + it) & 7; }
        else { const int unit = it * G + blk; if (unit >= NBATCH * NHEAD * 8) break; bh = unit & 255; qb = unit >> 8; }
        const int b = bh >> 4, h = bh & 15;
        __syncthreads();
        if (MODE == 0) { for (int i = tid; i < 639; i += 512) { int d = 575 - i; d = d < -256 ? -256 : (d > 256 ? 256 : d); T[i] = bias_src[h * NREL + d + 256] * LOG2E; } }
        else { for (int i = tid; i < (qb + 1) * 256; i += 512) T[i] = bias_src[(size_t)bh * SEQ + i]; }
        const int qrow = qb * 256 + w * 32 + c;
        const bf16_t* qp = PROJ + (size_t)(b * SEQ + qrow) * NA + h * HD + 8 * hi;
        bf16x8 qf[8];
#pragma unroll
        for (int s = 0; s < 8; ++s) qf[s] = *(const bf16x8*)(qp + 16 * s);
        const int kt_hi = 4 * qb + 3, kt_lo = MODE == 0 ? (4 * qb - 8 > 0 ? 4 * qb - 8 : 0) : 0;
        const int cw = 4 * qb + (w >> 1);
        const bf16_t* kg = PROJ + (size_t)(b * SEQ + srow) * NA + DM + h * HD + sch * 8;
        u32x4 st0, st1, st2, st3;
        { const bf16_t* g0 = kg + (size_t)kt_hi * 64 * NA;
          st0 = *(const u32x4*)g0; st1 = *(const u32x4*)(g0 + (size_t)32 * NA); st2 = *(const u32x4*)(g0 + DM); st3 = *(const u32x4*)(g0 + (size_t)32 * NA + DM); }
        *(LAS u32x4*)(L + soff0) = st0; *(LAS u32x4*)(L + soff1) = st1; *(LAS u32x4*)(L + 32768 + soff0) = st2; *(LAS u32x4*)(L + 32768 + soff1) = st3;
        f32x16 o0, o1, o2, o3;
#pragma unroll
        for (int r = 0; r < 16; ++r) { o0[r] = 0.f; o1[r] = 0.f; o2[r] = 0.f; o3[r] = 0.f; }
        float mrun = -1e30f, lrun = 0.f;
        const float cfar = MODE == 0 ? bias_src[h * NREL + 512] * LOG2E : 0.f;
#pragma unroll
        for (int s = 0; s < 8; ++s) asm volatile("" : "+v"(qf[s]));
        __syncthreads();
        int cur = 0;
        for (int kt = kt_hi; kt >= kt_lo; --kt) {
            const bool more = kt > kt_lo;
#define PREFETCH_NEXT() if (more) { const bf16_t* g0 = kg + (size_t)(kt - 1) * 64 * NA; \
                st0 = *(const u32x4*)g0; st1 = *(const u32x4*)(g0 + (size_t)32 * NA); st2 = *(const u32x4*)(g0 + DM); st3 = *(const u32x4*)(g0 + (size_t)32 * NA + DM); }
            const bool active = MODE == 0 ? (kt >= cw - 8 && kt <= cw) : (kt <= cw);
            PREFETCH_NEXT()
            if (active) {
                LAS unsigned char* Kb = L + cur * 16384; LAS unsigned char* Vb = L + 32768 + cur * 16384;
                unsigned kaddr_t = kaddr, vb_t = vb; asm volatile("" : "+v"(kaddr_t), "+v"(vb_t));
                unsigned va[4][2];
#pragma unroll
                for (int db = 0; db < 4; ++db)
#pragma unroll
                    for (int t = 0; t < 2; ++t) va[db][t] = vbase0 + (vb_t ^ (unsigned)(64 * db + 32 * t)) + 2048u * t;
                f32x16 s0, s1;
                if (MODE == 0) {
                    if (kt <= cw - 5) {
#pragma unroll
                        for (int r = 0; r < 16; ++r) { s0[r] = cfar; s1[r] = cfar; }
                    } else { const LAS float* tb = T + (575 - (qrow - kt * 64) + 4 * hi);
#pragma unroll
                        for (int r = 0; r < 16; ++r) { const int cr = (r & 3) + 8 * (r >> 2); s0[r] = tb[cr]; s1[r] = tb[32 + cr]; } } }
                else { const int base = kt * 64 + 4 * hi;
#pragma unroll
                    for (int r = 0; r < 16; ++r) { const int cr = (r & 3) + 8 * (r >> 2); s0[r] = T[base + cr]; s1[r] = T[base + 32 + cr]; } }
#define KLOAD(D0, D1, S) { const unsigned a_ = kaddr_t ^ (unsigned)((S) << 5); D0 = *(const LAS bf16x8*)(Kb + a_); D1 = *(const LAS bf16x8*)(Kb + a_ + 8192); }
#define QK2(A0, A1, B0, B1, S) { s0 = MFMA32(A0, qf[S], s0); s1 = MFMA32(A1, qf[S], s1); s0 = MFMA32(B0, qf[(S) + 1], s0); s1 = MFMA32(B1, qf[(S) + 1], s1); }
#define VLOAD(DST, DB) { _Pragma("unroll") for (int ks = 0; ks < 4; ++ks) { \
                    const s16x4 lo = __builtin_amdgcn_ds_read_tr16_b64_v4i16((LAS s16x4*)(Vb + va[DB][0] + 4096 * ks)); \
                    const s16x4 hh = __builtin_amdgcn_ds_read_tr16_b64_v4i16((LAS s16x4*)(Vb + va[DB][1] + 4096 * ks)); \
                    DST[ks] = __builtin_shufflevector(lo, hh, 0, 1, 2, 3, 4, 5, 6, 7); } }
#define PV4(OD, SRC) { _Pragma("unroll") for (int ks = 0; ks < 4; ++ks) OD = MFMA32(SRC[ks], pb[ks], OD); }
#define SGB_DS_MFMA(NDS) { __builtin_amdgcn_sched_group_barrier(0x100, NDS, 0); __builtin_amdgcn_sched_group_barrier(0x008, 4, 0); }
                bf16x8 ka0, ka1, ka2, ka3, kb0, kb1, kb2, kb3, vA[4], vB[4];
                KLOAD(ka0, ka1, 0) KLOAD(ka2, ka3, 1)
                __builtin_amdgcn_sched_barrier(0);
                KLOAD(kb0, kb1, 2) KLOAD(kb2, kb3, 3) QK2(ka0, ka1, ka2, ka3, 0) SGB_DS_MFMA(4)
                __builtin_amdgcn_sched_barrier(0);
                KLOAD(ka0, ka1, 4) KLOAD(ka2, ka3, 5) QK2(kb0, kb1, kb2, kb3, 2) SGB_DS_MFMA(4)
                __builtin_amdgcn_sched_barrier(0);
                KLOAD(kb0, kb1, 6) KLOAD(kb2, kb3, 7) QK2(ka0, ka1, ka2, ka3, 4) SGB_DS_MFMA(4)
                __builtin_amdgcn_sched_barrier(0);
                VLOAD(vA, 0) QK2(kb0, kb1, kb2, kb3, 6) SGB_DS_MFMA(8)
                __builtin_amdgcn_sched_barrier(0);
                if (MODE == 1 && kt == cw) {
                    const int rel = qrow - kt * 64 - 4 * hi;
#pragma unroll
                    for (int r = 0; r < 16; ++r) { const int cr = (r & 3) + 8 * (r >> 2);
                        s0[r] = cr <= rel ? s0[r] : -__builtin_inff(); s1[r] = cr + 32 <= rel ? s1[r] : -__builtin_inff(); } }
                float mx;
                { float m8[8];
#pragma unroll
                  for (int r = 0; r < 8; ++r) m8[r] = fmaxf(fmaxf(s0[r], s1[r]), fmaxf(s0[r + 8], s1[r + 8]));
                  mx = fmaxf(fmaxf(fmaxf(m8[0], m8[1]), fmaxf(m8[2], m8[3])), fmaxf(fmaxf(m8[4], m8[5]), fmaxf(m8[6], m8[7]))); }
                { const auto rr = __builtin_amdgcn_permlane32_swap(__float_as_uint(mx), __float_as_uint(mx), false, false); mx = fmaxf(__uint_as_float(rr[0]), __uint_as_float(rr[1])); }
                if (!__all(mx <= mrun + 8.0f)) {
                    const float mn = fmaxf(mrun, mx), alpha = __builtin_amdgcn_exp2f(mrun - mn); mrun = mn;
                    lrun *= alpha; o0 *= alpha; o1 *= alpha; o2 *= alpha; o3 *= alpha; }
#pragma unroll
                for (int r = 0; r < 16; ++r) { s0[r] = __builtin_amdgcn_exp2f(s0[r] - mrun); s1[r] = __builtin_amdgcn_exp2f(s1[r] - mrun); }
                { float p8[8];
#pragma unroll
                  for (int r = 0; r < 8; ++r) p8[r] = (s0[r] + s1[r]) + (s0[r + 8] + s1[r + 8]);
                  lrun += ((p8[0] + p8[1]) + (p8[2] + p8[3])) + ((p8[4] + p8[5]) + (p8[6] + p8[7])); }
                bf16x8 pb[4];
#pragma unroll
                for (int ks = 0; ks < 2; ++ks) { u32x4 a, bq;
                    a.x = pk2(s0[8 * ks + 0], s0[8 * ks + 1]); a.y = pk2(s0[8 * ks + 2], s0[8 * ks + 3]); a.z = pk2(s0[8 * ks + 4], s0[8 * ks + 5]); a.w = pk2(s0[8 * ks + 6], s0[8 * ks + 7]);
                    bq.x = pk2(s1[8 * ks + 0], s1[8 * ks + 1]); bq.y = pk2(s1[8 * ks + 2], s1[8 * ks + 3]); bq.z = pk2(s1[8 * ks + 4], s1[8 * ks + 5]); bq.w = pk2(s1[8 * ks + 6], s1[8 * ks + 7]);
                    pb[ks] = __builtin_bit_cast(bf16x8, a); pb[2 + ks] = __builtin_bit_cast(bf16x8, bq); }
                __builtin_amdgcn_sched_barrier(0);
                VLOAD(vB, 1) PV4(o0, vA) SGB_DS_MFMA(8)
                __builtin_amdgcn_sched_barrier(0);
                VLOAD(vA, 2) PV4(o1, vB) SGB_DS_MFMA(8)
                __builtin_amdgcn_sched_barrier(0);
                VLOAD(vB, 3) PV4(o2, vA) SGB_DS_MFMA(8)
                __builtin_amdgcn_sched_barrier(0);
                PV4(o3, vB)
                __builtin_amdgcn_sched_barrier(0);
#undef KLOAD
#undef QK2
#undef VLOAD
#undef PV4
#undef SGB_DS_MFMA
            }
#undef PREFETCH_NEXT
            if (more) { LAS unsigned char* Kn = L + (cur ^ 1) * 16384; LAS unsigned char* Vn = L + 32768 + (cur ^ 1) * 16384;
                *(LAS u32x4*)(Kn + soff0) = st0; *(LAS u32x4*)(Kn + soff1) = st1; *(LAS u32x4*)(Vn + soff0) = st2; *(LAS u32x4*)(Vn + soff1) = st3; }
            __syncthreads();
            cur ^= 1;
        }
        lrun += __shfl_xor(lrun, 32);
        const float inv = 1.0f / lrun;
        const bf16_t* gp = PROJ + (size_t)(b * SEQ + qrow) * NA + 3 * DM + h * HD + 8 * hi;
        bf16_t* op = ACT + (size_t)(b * SEQ + qrow) * DM + h * HD + 8 * hi;
#define O_STORE(OD, DB) _Pragma("unroll") for (int pr = 0; pr < 2; ++pr) { const u32x4 sw = *(const u32x4*)(gp + 32 * DB + 16 * pr); \
            const auto gx = __builtin_amdgcn_permlane32_swap(sw.x, sw.z, false, false); const auto gy = __builtin_amdgcn_permlane32_swap(sw.y, sw.w, false, false); \
              \
            const unsigned ax = pk2(OD[8 * pr + 0] * inv * bflo(gx[0]), OD[8 * pr + 1] * inv * bfhi(gx[0])), ay = pk2(OD[8 * pr + 2] * inv * bflo(gy[0]), OD[8 * pr + 3] * inv * bfhi(gy[0])); \
            const unsigned bx = pk2(OD[8 * pr + 4] * inv * bflo(gx[1]), OD[8 * pr + 5] * inv * bfhi(gx[1])), by = pk2(OD[8 * pr + 6] * inv * bflo(gy[1]), OD[8 * pr + 7] * inv * bfhi(gy[1])); \
            const auto ox = __builtin_amdgcn_permlane32_swap(ax, bx, false, false); const auto oy = __builtin_amdgcn_permlane32_swap(ay, by, false, false); \
            u32x4 ov; ov.x = ox[0]; ov.y = oy[0]; ov.z = ox[1]; ov.w = oy[1]; \
            *(u32x4*)(op + 32 * DB + 16 * pr) = ov; }
        O_STORE(o0, 0) O_STORE(o1, 1) O_STORE(o2, 2) O_STORE(o3, 3)
#undef O_STORE
    }
}

#define MFMA16(a, b, c) __builtin_amdgcn_mfma_f32_16x16x32_bf16((a), (b), (c), 0, 0, 0)
constexpr int XC_LD = 168;
template <bool LDSW>
__device__ __forceinline__ void rglru_tiles(const LAS bf16_t* XC, const bf16x8 (&WA)[5], const bf16x8 (&WX)[5], const LAS bf16x8* WL, float BA, float BX, float SP, int col, int fr, int fq, int lane,
                                            float& hc, const bf16_t* sgb, bf16_t* outb) {
    unsigned sgo = (unsigned)(4 * fq * NBP + col), outo = (unsigned)(4 * fq * RGW + col); asm volatile("" : "+v"(sgo), "+v"(outo));
    float a_[4][4], u_[4][4];
#pragma unroll
    for (int rt = 0; rt < 4; ++rt) { f32x4 aa = {0.f, 0.f, 0.f, 0.f}, ax = {0.f, 0.f, 0.f, 0.f};
#pragma unroll
        for (int ks = 0; ks < 5; ++ks) { const bf16x8 af = *(const LAS bf16x8*)(XC + (rt * 16 + fr) * XC_LD + 32 * ks + 8 * fq);
            const bf16x8 wa = LDSW ? WL[ks * 64 + lane] : WA[ks], wx = LDSW ? WL[(5 + ks) * 64 + lane] : WX[ks]; aa = MFMA16(af, wa, aa); ax = MFMA16(af, wx, ax); }
#pragma unroll
        for (int rg = 0; rg < 4; ++rg) { const int t = rt * 16 + fq * 4 + rg;
            const float r = fast_sigmoid(aa[rg] + BA), ig = fast_sigmoid(ax[rg] + BX); const float a = __builtin_amdgcn_exp2f(SP * r);
            const float xv = __uint_as_float((unsigned)XC[t * XC_LD + col] << 16);
            a_[rt][rg] = a; u_[rt][rg] = __builtin_amdgcn_sqrtf(fmaxf(1.0f - a * a, 0.f)) * ig * xv; } }
    unsigned short sg[4][4];
#pragma unroll
    for (int rt = 0; rt < 4; ++rt)
#pragma unroll
        for (int rg = 0; rg < 4; ++rg) sg[rt][rg] = sgb[sgo + (unsigned)((16 * rt + rg) * NBP)];
    float A[4], U[4];
#pragma unroll
    for (int rt = 0; rt < 4; ++rt) { float a = a_[rt][0], u = u_[rt][0];
#pragma unroll
        for (int rg = 1; rg < 4; ++rg) { u = a_[rt][rg] * u + u_[rt][rg]; a *= a_[rt][rg]; }
        A[rt] = a; U[rt] = u; }
#pragma unroll
    for (int d = 16; d <= 32; d <<= 1)
#pragma unroll
        for (int rt = 0; rt < 4; ++rt) { const float ap = __shfl_up(A[rt], d), up = __shfl_up(U[rt], d);
            if (lane >= d) { U[rt] = A[rt] * up + U[rt]; A[rt] *= ap; } }
    float Ae[4], Ue[4], At[4], Ut[4];
#pragma unroll
    for (int rt = 0; rt < 4; ++rt) { const float ap = __shfl_up(A[rt], 16), up = __shfl_up(U[rt], 16); Ae[rt] = fq ? ap : 1.0f; Ue[rt] = fq ? up : 0.0f;
        At[rt] = __shfl(A[rt], 48 + fr); Ut[rt] = __shfl(U[rt], 48 + fr); }
    float h = hc;
#pragma unroll
    for (int rt = 0; rt < 4; ++rt) { float hh = Ae[rt] * h + Ue[rt];
#pragma unroll
        for (int rg = 0; rg < 4; ++rg) { hh = a_[rt][rg] * hh + u_[rt][rg];
            const float o = hh * __uint_as_float((unsigned)sg[rt][rg] << 16);
            outb[outo + (unsigned)((16 * rt + rg) * RGW)] = (bf16_t)(pk2(o, 0.f) & 0xffffu); }
        h = At[rt] * h + Ut[rt]; }
    hc = h;
}
struct RgSplit { float a[4], u[4], Ae, Ue; unsigned short sg[4]; };
__device__ __forceinline__ void rglru_split1(const LAS bf16_t* XC, const LAS bf16x8* WL, float BA, float BX, float SP, int col, int rt, int fr, int fq, int lane, LAS f32x2* TOT, const bf16_t* sgb, RgSplit& st) {
    unsigned sgo = (unsigned)((16 * rt + 4 * fq) * NBP + col); asm volatile("" : "+v"(sgo));
#pragma unroll
    for (int rg = 0; rg < 4; ++rg) st.sg[rg] = sgb[sgo + (unsigned)(rg * NBP)];
    f32x4 aa = {0.f, 0.f, 0.f, 0.f}, ax = {0.f, 0.f, 0.f, 0.f};
#pragma unroll
    for (int ks = 0; ks < 5; ++ks) { const bf16x8 af = *(const LAS bf16x8*)(XC + (rt * 16 + fr) * XC_LD + 32 * ks + 8 * fq); aa = MFMA16(af, WL[ks * 64 + lane], aa); ax = MFMA16(af, WL[(5 + ks) * 64 + lane], ax); }
#pragma unroll
    for (int rg = 0; rg < 4; ++rg) { const int t = rt * 16 + fq * 4 + rg;
        const float r = fast_sigmoid(aa[rg] + BA), ig = fast_sigmoid(ax[rg] + BX); const float a = __builtin_amdgcn_exp2f(SP * r);
        const float xv = __uint_as_float((unsigned)XC[t * XC_LD + col] << 16);
        st.a[rg] = a; st.u[rg] = __builtin_amdgcn_sqrtf(fmaxf(1.0f - a * a, 0.f)) * ig * xv; }
    float A = st.a[0], U = st.u[0];
#pragma unroll
    for (int rg = 1; rg < 4; ++rg) { U = st.a[rg] * U + st.u[rg]; A *= st.a[rg]; }
#pragma unroll
    for (int d = 16; d <= 32; d <<= 1) { const float ap = __shfl_up(A, d), up = __shfl_up(U, d); if (lane >= d) { U = A * up + U; A *= ap; } }
    { const float ap = __shfl_up(A, 16), up = __shfl_up(U, 16); st.Ae = fq ? ap : 1.0f; st.Ue = fq ? up : 0.0f; }
    if (fq == 3) TOT[rt * 16 + fr] = (f32x2){A, U};
}
__device__ __forceinline__ void rglru_split2(const LAS f32x2* TOT, int col, int rtA, int fr, int fq, float& hc, bf16_t* outb, const RgSplit& sa, const RgSplit& sb) {
    float h = hc, hinA = hc, hinB = hc;
#pragma unroll
    for (int r2 = 0; r2 < 8; ++r2) { const f32x2 t = TOT[r2 * 16 + fr]; if (r2 == rtA) hinA = h; if (r2 == rtA + 4) hinB = h; h = t.x * h + t.y; }
    hc = h;
#pragma unroll
    for (int half = 0; half < 2; ++half) { const RgSplit& st = half ? sb : sa; const int rt = rtA + 4 * half;
        unsigned outo = (unsigned)((16 * rt + 4 * fq) * RGW + col); asm volatile("" : "+v"(outo));
        float hh = st.Ae * (half ? hinB : hinA) + st.Ue;
#pragma unroll
        for (int rg = 0; rg < 4; ++rg) { hh = st.a[rg] * hh + st.u[rg];
            const float o = hh * __uint_as_float((unsigned)st.sg[rg] << 16);
            outb[outo + (unsigned)(rg * RGW)] = (bf16_t)(pk2(o, 0.f) & 0xffffu); } }
}
__device__ __forceinline__ void rglru_phase(LAS unsigned char* L, const bf16_t* PROJ, bf16_t* ACT, const float* conv_w, const float* conv_b, const bf16x8* GW, const float* gab,
                                            const float* gxb, const float* lam, int G, int blk, const int tid) {
    const int lane = tid & 63, w = __builtin_amdgcn_readfirstlane(tid >> 6), fr = lane & 15, fq = lane >> 4;
    LAS bf16_t* XC = (LAS bf16_t*)L;
    LAS bf16_t* XR = (LAS bf16_t*)(L + 43008);
    LAS float* CW = (LAS float*)(L + 43008 + 44032);
    for (int unit = blk; unit < NBATCH * 16; unit += G) {
        int b = unit >> 4, nb = unit & 15;
        if (G == 256) { const int x = blk & 7, j = blk >> 3; b = 2 * x + (j >> 4); nb = j & 15; }
        const int ch0 = nb * 160;
        __syncthreads();
        for (int i = tid; i < 800; i += 512) { const int j = i / 160, ch = i - j * 160; CW[i] = j < 4 ? conv_w[j * RGW + ch0 + ch] : conv_b[ch0 + ch]; }
        bf16x8 wa0[5], wx0[5];
        LAS bf16x8* WL = (LAS bf16x8*)(L + 43008 + 44032 + 3200) + (w >> 2) * 640;
        LAS f32x2* TOT = (LAS f32x2*)(L + 43008 + 44032 + 3200 + 20480) + (w >> 2) * 128;
        const int w1 = 8 + (w >> 2), rt1 = w & 3;
        const int col0 = w * 16 + fr, col1 = w1 * 16 + fr;
        { const bf16x8* ga0 = GW + ((size_t)((0 * 16 + nb) * 10 + w) * 5) * 64 + lane; const bf16x8* gx0 = GW + ((size_t)((1 * 16 + nb) * 10 + w) * 5) * 64 + lane;
          const bf16x8* ga1 = GW + ((size_t)((0 * 16 + nb) * 10 + w1) * 5) * 64 + lane; const bf16x8* gx1 = GW + ((size_t)((1 * 16 + nb) * 10 + w1) * 5) * 64 + lane;
#pragma unroll
          for (int ks = 0; ks < 5; ++ks) { wa0[ks] = ga0[ks * 64]; wx0[ks] = gx0[ks * 64]; if ((w & 3) == 0) { WL[ks * 64 + lane] = ga1[ks * 64]; WL[(5 + ks) * 64 + lane] = gx1[ks * 64]; } } }
        const float ba0 = gab[ch0 + col0], bx0 = gxb[ch0 + col0], ba1 = gab[ch0 + col1], bx1 = gxb[ch0 + col1];
        const float l0 = lam[ch0 + col0], l1 = lam[ch0 + col1];
        const float sp0 = -8.0f * LOG2E * (fmaxf(-l0, 0.f) + log1pexp_neg_abs(l0)), sp1 = -8.0f * LOG2E * (fmaxf(-l1, 0.f) + log1pexp_neg_abs(l1));
        float hc0 = 0.f, hc1 = 0.f;
        u32x2 xs[11];
        const bf16_t* xbase = PROJ + (size_t)b * SEQ * NBP + ch0;
#define XR_LOAD(T0) { _Pragma("unroll") for (int k = 0; k < 11; ++k) { const int i = tidc + 512 * k, r = i / 40, c4 = (i - r * 40) * 4, tt = (T0) - 3 + r; \
            xs[k] = (u32x2){0u, 0u}; if (i < 5240 && tt >= 0) xs[k] = *(const u32x2*)(xbase + (size_t)tt * NBP + c4); } }
#define XR_STORE() { _Pragma("unroll") for (int k = 0; k < 11; ++k) { const int i = tidc + 512 * k, r = i / 40, c4 = (i - r * 40) * 4; if (i < 5240) *(LAS u32x2*)(XR + r * XC_LD + c4) = xs[k]; } }
        { int tidc = tid; asm volatile("" : "+v"(tidc)); XR_LOAD(0) XR_STORE() }
        __syncthreads();
        for (int chunk = 0; chunk < SEQ / 128; ++chunk) {
            const int t0 = chunk * 128;
            int tidc = tid; asm volatile("" : "+v"(tidc));
#pragma unroll 5
            for (int it = 0; it < 10; ++it) { const int i = tidc + 512 * it, t = i / 40, c4 = (i - t * 40) * 4;
                f32x4 acc = *(const LAS f32x4*)(CW + 640 + c4);
#pragma unroll
                for (int j = 0; j < 4; ++j) { const u32x2 xv = *(const LAS u32x2*)(XR + (t + j) * XC_LD + c4); const f32x4 cw4 = *(const LAS f32x4*)(CW + j * 160 + c4);
                    acc.x += bflo(xv.x) * cw4.x; acc.y += bfhi(xv.x) * cw4.y; acc.z += bflo(xv.y) * cw4.z; acc.w += bfhi(xv.y) * cw4.w; }
                u32x2 o; o.x = pk2(acc.x, acc.y); o.y = pk2(acc.z, acc.w); *(LAS u32x2*)(XC + t * XC_LD + c4) = o; }
            if (chunk + 1 < SEQ / 128) XR_LOAD(t0 + 128)
            __syncthreads();
            if (chunk + 1 < SEQ / 128) XR_STORE()
            const size_t trow = (size_t)(b * SEQ + t0);
            RgSplit spa, spb;
            rglru_tiles<false>(XC, wa0, wx0, WL, ba0, bx0, sp0, col0, fr, fq, lane, hc0, PROJ + trow * NBP + RGW + ch0, ACT + trow * RGW + ch0);
            rglru_tiles<false>(XC + 64 * XC_LD, wa0, wx0, WL, ba0, bx0, sp0, col0, fr, fq, lane, hc0, PROJ + (trow + 64) * NBP + RGW + ch0, ACT + (trow + 64) * RGW + ch0);
            rglru_split1(XC, WL, ba1, bx1, sp1, col1, rt1, fr, fq, lane, TOT, PROJ + trow * NBP + RGW + ch0, spa);
            rglru_split1(XC, WL, ba1, bx1, sp1, col1, rt1 + 4, fr, fq, lane, TOT, PROJ + trow * NBP + RGW + ch0, spb);
            __syncthreads();
            rglru_split2(TOT, col1, rt1, fr, fq, hc1, ACT + trow * RGW + ch0, spa, spb);
        }
#undef XR_LOAD
#undef XR_STORE
    }
}

#define XB_TMO      128
#define XB_XCNT(j)  (256  + 64 * (j))
#define XB_XSUB(j)  (1280 + 64 * (j))
#define XB_XGEN(j)  (2304 + 64 * (j))
#define XB_TOP      3328
#define XB_TOPGEN   3392
#define XCD_BAR_WORDS 3456
#define XB_SPIN_CAP (1u << 18)

__device__ __forceinline__ unsigned xb_ld(unsigned* p)              { return __hip_atomic_load(p, __ATOMIC_RELAXED, __HIP_MEMORY_SCOPE_AGENT); }
__device__ __forceinline__ unsigned xb_add(unsigned* p, unsigned v) { return __hip_atomic_fetch_add(p, v, __ATOMIC_RELAXED, __HIP_MEMORY_SCOPE_AGENT); }
__device__ __forceinline__ unsigned xb_xcc_id() { return (unsigned)__builtin_amdgcn_s_getreg((3 << 11) | 20) & 0xFu; }
#define XB_SPIN(cond, bar) do { unsigned _sp = 0; while (cond) { __builtin_amdgcn_s_sleep(1); \
    if ((++_sp & 255u) == 0u) { if (xb_ld(&(bar)[XB_TMO])) break; if (_sp > XB_SPIN_CAP) { atomicAdd(&(bar)[XB_TMO], 1u); break; } } } } while (0)

struct XcdBarrier {
    unsigned* bar; unsigned x;
    volatile LAS unsigned* st;
};

__device__ __forceinline__ XcdBarrier xcd_barrier_post(unsigned* bar, volatile LAS unsigned* st) {
    XcdBarrier b; b.bar = bar; b.x = xb_xcc_id(); b.st = st;
    if (threadIdx.x == 0) (void)xb_add(&bar[XB_XCNT(b.x)], 1u);
    return b;
}
__device__ __forceinline__ void xcd_barrier_complete(unsigned* bar, unsigned x, unsigned& nloc, unsigned& nx) {
    const unsigned G = gridDim.x * gridDim.y * gridDim.z;
    unsigned sum, cnt, mine, sp = 0u;
    for (;;) {
        sum = 0u; cnt = 0u; mine = 0u;
#pragma unroll
        for (unsigned j = 0; j < 16; ++j) { const unsigned c = xb_ld(&bar[XB_XCNT(j)]); sum += c; cnt += (c > 0u) ? 1u : 0u; mine = (j == x) ? c : mine; }
        if (sum == G) break;
        __builtin_amdgcn_s_sleep(1);
        if ((++sp & 255u) == 0u) { if (xb_ld(&bar[XB_TMO])) break; if (sp > XB_SPIN_CAP) { atomicAdd(&bar[XB_TMO], 1u); break; } }
    }
    nloc = mine > 0u ? mine : 1u; nx = cnt > 0u ? cnt : 1u;
}

__device__ __forceinline__ void xcd_barrier(const XcdBarrier& b) {
    asm volatile("s_waitcnt vmcnt(0)" ::: "memory");
    __syncthreads();
    if (threadIdx.x == 0) {
        unsigned* bar = b.bar;
        __builtin_amdgcn_s_waitcnt(0);
        unsigned nloc = b.st[0], nx = b.st[1];
        if (nloc == 0u) { xcd_barrier_complete(bar, b.x, nloc, nx); b.st[0] = nloc; b.st[1] = nx; }
        const unsigned old = xb_add(&bar[XB_XSUB(b.x)], 1u);
        const unsigned gen = old / nloc;
        if (old + 1u == (gen + 1u) * nloc) {
            __builtin_amdgcn_fence(__ATOMIC_RELEASE, "agent");
            asm volatile("s_waitcnt vmcnt(0)" ::: "memory");
            const unsigned og = xb_add(&bar[XB_TOP], 1u);
            const unsigned tg = og / nx;
            if (og + 1u == (tg + 1u) * nx) xb_add(&bar[XB_TOPGEN], 1u);
            else XB_SPIN(xb_ld(&bar[XB_TOPGEN]) == tg, bar);
            __builtin_amdgcn_fence(__ATOMIC_ACQUIRE, "agent");
            xb_add(&bar[XB_XGEN(b.x)], 1u);
            asm volatile("s_waitcnt vmcnt(0)" ::: "memory");
        } else {
            XB_SPIN(xb_ld(&bar[XB_XGEN(b.x)]) == gen, bar);
            __builtin_amdgcn_fence(__ATOMIC_ACQUIRE, "agent");
            asm volatile("s_waitcnt vmcnt(0)" ::: "memory");
        }
    }
    __syncthreads();
}

#ifndef MK_LAUNCHES
#define MK_LAUNCHES 1
#endif
#ifndef FUSE_ROW
#define FUSE_ROW 1
#endif
#ifndef ROW_NR
#define ROW_NR 2
#endif
#ifndef GEMM_SP2
#define GEMM_SP2 true
#endif
#ifndef GEMM_ALIGN
#define GEMM_ALIGN true
#endif
#ifndef STAGGER_TICKS
#define STAGGER_TICKS 0
#endif
#ifndef PROBE_REPEAT_MASK
#define PROBE_REPEAT_MASK 0x0
#endif
__global__ void __launch_bounds__(512, 2) hybrid_trunk_mega(Params p) {
    extern __shared__ __attribute__((aligned(16))) unsigned char lds_raw[];
    LAS unsigned char* L = (LAS unsigned char*)lds_raw;
    cg::grid_group grid = cg::this_grid();
    if (threadIdx.x < 4) ((LAS unsigned*)(L + LDS_BYTES - 16))[threadIdx.x] = 0u;
    __syncthreads();
    XcdBarrier xbar = xcd_barrier_post((unsigned*)(p.ws + WS_BAR), (volatile LAS unsigned*)(L + LDS_BYTES - 16));
    const int G = gridDim.x, blk = blockIdx.x;
    unsigned char* ws = p.ws;
    bf16_t* ACT = (bf16_t*)(ws + WS_ACT); bf16_t* XB = (bf16_t*)(ws + WS_XB); float* XS = (float*)(ws + WS_XS); float* YS = (float*)(ws + WS_YS); unsigned* CNT = (unsigned*)(ws + WS_CNT); bf16_t* PROJ = (bf16_t*)(ws + WS_PROJ); bf16_t* YB = (bf16_t*)(ws + WS_PROJ);
    float* LOGF = (float*)(ws + WS_LOGF); float* CUMB = (float*)(ws + WS_CUMB);
    const bool fused = FUSE_ROW != 0;
    for (int ph = p.ph_lo; ph < p.ph_hi; ++ph) {
      if (fused && ph > 0 && ((ph - 1) & 3) == 3 && ((ph - 1) >> 2) != 1) continue;
      {
        int tid = threadIdx.x; asm volatile("" : "+v"(tid));
        const int lane = tid & 63, wave = __builtin_amdgcn_readfirstlane(tid >> 6);
        if (ph == 0) {
#ifndef SKIP_PRO
            prologue_phase(p, L, G, blk, wave, lane);
#endif
        }
        else {
            const int layer = (ph - 1) >> 2, sub = (ph - 1) & 3, mix = layer % 3, j = layer / 3;
            if (sub == 0) {
                const bf16_t* Wt = mix == 0 ? (const bf16_t*)(ws + WS_WA_IN + (size_t)j * 32 * MiB) : mix == 1 ? (const bf16_t*)(ws + WS_WB_IN) : (const bf16_t*)(ws + WS_WC_IN);
                const int N = mix == 1 ? NBP : NA;
                if (mix == 2) cumsum_phase(LOGF, CUMB, (LAS float*)L, G, blk, tid);
                pg8::Gemm g{XB, Wt, MTOK, N, DM}; pg8::StaticOrder S; S.init(MTOK, N, G, blk);
                LAS float* RS = (LAS float*)(L + 131072);
                if (G == 256) { const int pmA = 16 * (blk & 7) + ((blk >> 3) & 7);
                    RS[tid] = 1.0f / sqrtf(pg8::slot_sum8(XS + ((size_t)layer * MTOK + (pmA + 8 * (tid >> 8)) * 256 + (tid & 255)) * 8) * (1.0f / DM) + RMS_EPS); __syncthreads(); }
                pg8::EpiProj E{PROJ, N, mix == 1 ? 0 : DM, QSCALE, mix == 1 ? RGW : 3 * DM, XS + (size_t)layer * MTOK * 8, G == 256 ? (const LAS float*)RS : (const LAS float*)nullptr};
#if STAGGER_TICKS > 0
                { const unsigned long long t_end = __builtin_amdgcn_s_memrealtime() + (unsigned long long)(((blk >> 3) & 15) * STAGGER_TICKS);
                  while (__builtin_amdgcn_s_memrealtime() < t_end) __builtin_amdgcn_s_sleep(8); }
#endif
#ifndef SKIP_GEMM1
                pg8::gemm_phase2<pg8::EpiProj, pg8::StaticOrder, GEMM_ALIGN, GEMM_SP2>(L, g, S, E, tid);
#endif
            } else if (sub == 1) {
#ifndef SKIP_ATTN0
                if (mix == 0) attn_phase<0>(L, PROJ, ACT, p.in[4] + (size_t)j * NHEAD * NREL, G, blk, tid);
#endif
#ifndef SKIP_RGLRU
                if (mix == 1) rglru_phase(L, PROJ, ACT, p.in[7], p.in[8], (const bf16x8*)(ws + WS_GW), p.in[10], p.in[12], p.in[13], G, blk, tid);
#endif
#ifndef SKIP_ATTN1
                if (mix == 2) attn_phase<1>(L, PROJ, ACT, CUMB, G, blk, tid);
#endif
            } else if (sub == 2) {
                const bf16_t* Wt = mix == 0 ? (const bf16_t*)(ws + WS_WA_OUT + (size_t)j * 8 * MiB) : mix == 1 ? (const bf16_t*)(ws + WS_WB_OUT) : (const bf16_t*)(ws + WS_WC_OUT);
                const int K = mix == 1 ? RGW : DM;
                pg8::Gemm g{ACT, Wt, MTOK, DM, K}; pg8::StaticOrder S; S.init(MTOK, DM, G, blk);
#ifndef SKIP_GEMM2
                if (fused) {
                    pg8::PanelOrder PO{blk};
                    static_assert(pg8::FUSE_XB == WS_XB && pg8::FUSE_XS == WS_XS && pg8::FUSE_YS == WS_YS && pg8::FUSE_CNT == WS_CNT, "fused-epilogue buffer offsets");
                    pg8::EpiFuse EF{ws, layer == 3 ? p.out : nullptr, p.in[2] + (size_t)layer * DM, layer, (LAS float*)(L + 133120)};
                    pg8::gemm_phase2<pg8::EpiFuse, pg8::PanelOrder, true, GEMM_SP2>(L, g, PO, EF, tid);
                }
#if !FUSE_ROW
                else {
                    pg8::EpiProj E{YB, DM, 0, 1.0f, 1 << 30, nullptr, nullptr};
                    pg8::gemm_phase2<pg8::EpiProj, pg8::StaticOrder, GEMM_ALIGN, GEMM_SP2>(L, g, S, E, tid);
                }
#endif
#endif
            } else {
                const float* gpre = layer < 3 ? p.in[1] + (size_t)(layer + 1) * DM : nullptr;
                const float* wf = (layer + 1) % 3 == 2 && layer < 3 ? p.in[15] + 4 * DM : nullptr;
#ifndef SKIP_ROW
                if (fused) { if (wf) flogit_phase(XB, XS + (size_t)(layer + 1) * MTOK * 8, gpre, wf, p.in[16], LOGF, blk * 8 + wave, G * 8, lane, (LAS float*)L, tid); }
#if !FUSE_ROW
                else if (layer == 0) row_phase<ROW_NR, true>(YB, p.in[0], XB, nullptr, p.in[2], XS + (size_t)MTOK * 8, gpre, nullptr, p.in[16], LOGF, blk * 8 + wave, G * 8, lane, (LAS float*)L, tid);
                else row_phase<ROW_NR, false>(YB, nullptr, XB, layer == 3 ? p.out : nullptr, p.in[2] + (size_t)layer * DM, XS + (size_t)(layer + 1) * MTOK * 8, gpre, wf, p.in[16], LOGF, blk * 8 + wave, G * 8, lane, (LAS float*)L, tid);
#endif
#endif
            }
        }
      }
        if (ph + 1 < p.ph_hi && !(fused && ph == NPHASE - 2)) { if (p.ph_lo < 0) grid.sync(); else xcd_barrier(xbar); }
    }
}

extern "C" void kernel_launch(void* const* d_in, const int* in_sizes, int n_in, void* d_out, int out_size, void* d_ws, size_t ws_size, hipStream_t stream) {
    static int grid = 0;
    if (grid == 0) {
        if (n_in != 18 || in_sizes[0] != MTOK * DM || out_size != MTOK * DM || ws_size < WS_END) {
            fprintf(stderr, "kernel_launch: unexpected shapes (n_in %d, in0 %d, out %d, ws %zu; need ws >= %zu)\n", n_in, n_in > 0 ? in_sizes[0] : -1, out_size, ws_size, (size_t)WS_END); grid = -1; return; }
        int dev = 0, cus = 0, per_cu = 0;
        (void)hipGetDevice(&dev); (void)hipDeviceGetAttribute(&cus, hipDeviceAttributeMultiprocessorCount, dev);
        if (hipFuncSetAttribute((const void*)hybrid_trunk_mega, hipFuncAttributeMaxDynamicSharedMemorySize, LDS_BYTES) != hipSuccess) { fprintf(stderr, "kernel_launch: hipFuncSetAttribute failed\n"); grid = -1; return; }
        if (hipOccupancyMaxActiveBlocksPerMultiprocessor(&per_cu, (const void*)hybrid_trunk_mega, 512, LDS_BYTES) != hipSuccess || per_cu < 1) { fprintf(stderr, "kernel_launch: occupancy query gave %d\n", per_cu); per_cu = 1; }
        (void)hipGetLastError();
        grid = cus * per_cu;
        if (FUSE_ROW && grid != 256) { fprintf(stderr, "kernel_launch: this build needs a 256-workgroup grid (got %d)\n", grid); grid = -1; return; }
    }
    if (grid < 0) return;
    if (hipMemsetAsync((char*)d_ws + WS_CTL, 0, CTL_BYTES, stream) != hipSuccess) { fprintf(stderr, "kernel_launch: memset of the barrier words failed\n"); return; }
    Params p{};
    for (int i = 0; i < 18; ++i) p.in[i] = (const float*)d_in[i];
    p.out = (float*)d_out; p.ws = (unsigned char*)d_ws;
#if MK_LAUNCHES == 1
    p.ph_lo = 0; p.ph_hi = NPHASE;
    void* args[] = {&p};
    const hipError_t e = hipLaunchCooperativeKernel((const void*)hybrid_trunk_mega, dim3(grid), dim3(512), args, LDS_BYTES, stream);
    if (e != hipSuccess) fprintf(stderr, "kernel_launch: cooperative launch failed: %s (grid %d)\n", hipGetErrorString(e), grid);
#else
    for (int ph = 0; ph < NPHASE; ++ph) { p.ph_lo = ph; p.ph_hi = ph + 1; hipLaunchKernelGGL(hybrid_trunk_mega, dim3(grid), dim3(512), LDS_BYTES, stream, p); }
#endif
}
```
